# Optimizing an MI355X kernel written in HIP

```python
import math
import jax, jax.numpy as jnp
from jax import lax
import numpy as np

D_MODEL = 1024
BATCH = 1
SEQ = 16384
DEPTH = 2

GRID_W = 64
CTX_LEN = 256
MIX_W = D_MODEL
POOL_W = MIX_W // 2
SSM_W = MIX_W - POOL_W
POOL_WINDOWS = (2, 4, 8, 16)
POOL_GROUPS = len(POOL_WINDOWS)
POOL_GW = POOL_W // POOL_GROUPS
SSM_GROUP = 16
SSM_GROUPS = SSM_W // SSM_GROUP
SSM_STATE = 64
N_EXPERTS = 32
N_EXPERT_GROUPS = 4
EXPERTS_PER_GROUP = N_EXPERTS // N_EXPERT_GROUPS
TOP_K = 2
D_EXPERT = D_MODEL // 2
ROUTE_BLOCK = 128
EPS = 1e-6
DT_MIN = 0.001
DT_MAX = 0.1
N_MOD = 6

kernel_name = "hybrid_pool_s5_moe_prefix_dit"


def rmsnorm(x, g):
    xf = x.astype(jnp.float32)
    y = xf * lax.rsqrt(jnp.mean(xf * xf, axis=-1, keepdims=True) + EPS)
    return (y * g.astype(jnp.float32)).astype(x.dtype)


def modulate(h, shift, scale):
    return h * (1 + scale) + shift


def centred_mean(u, w):
    n = u.shape[-2]
    cs = jnp.cumsum(u.astype(jnp.float32), axis=-2)
    cs = jnp.concatenate([jnp.zeros_like(cs[..., :1, :]), cs], axis=-2)
    t = np.arange(n)
    lo = np.maximum(t - w // 2, 0)
    hi = np.minimum(t + w // 2, n)
    s = jnp.take(cs, hi, axis=-2) - jnp.take(cs, lo, axis=-2)
    cnt = (hi - lo).astype(np.float32)[:, None]
    return (s / cnt).astype(u.dtype)


def pool_mixer(u, w_pool, s_pool):
    parts = []
    for g, w in enumerate(POOL_WINDOWS):
        ug = u[..., g * POOL_GW:(g + 1) * POOL_GW]
        parts.append(centred_mean(ug, w) - ug)
    p = jnp.stack(parts, axis=-2)
    y = jnp.einsum('...ngc,gcd->...ngd', p, w_pool)
    return y.reshape(u.shape) * s_pool


def ssm_discretise(a_re, a_im, log_dt, b_re, b_im):
    a_re = jnp.minimum(a_re.astype(jnp.float32), -1e-4)
    a_im = a_im.astype(jnp.float32)
    dt = jnp.exp(log_dt.astype(jnp.float32))[:, None]
    mag = jnp.exp(a_re * dt)
    lb_re = mag * jnp.cos(a_im * dt)
    lb_im = mag * jnp.sin(a_im * dt)
    num_re = lb_re - 1.0
    num_im = lb_im
    den = a_re * a_re + a_im * a_im
    k_re = (num_re * a_re + num_im * a_im) / den
    k_im = (num_im * a_re - num_re * a_im) / den
    b_re = b_re.astype(jnp.float32)
    b_im = b_im.astype(jnp.float32)
    bb_re = k_re[..., None] * b_re - k_im[..., None] * b_im
    bb_im = k_re[..., None] * b_im + k_im[..., None] * b_re
    return lb_re, lb_im, bb_re, bb_im


def _combine(e1, e2):
    a1r, a1i, b1r, b1i = e1
    a2r, a2i, b2r, b2i = e2
    return (a2r * a1r - a2i * a1i,
            a2r * a1i + a2i * a1r,
            a2r * b1r - a2i * b1i + b2r,
            a2r * b1i + a2i * b1r + b2i)


def ssm_scan(u, disc, h0, reverse):
    lb_re, lb_im, bb_re, bb_im = disc
    bsz, n, _ = u.shape
    ug = u.astype(jnp.float32).reshape(bsz, n, SSM_GROUPS, SSM_GROUP)
    bu_re = jnp.einsum('bngi,gpi->bngp', ug, bb_re)
    bu_im = jnp.einsum('bngi,gpi->bngp', ug, bb_im)
    if h0 is not None:
        h0r, h0i = h0
        idx = n - 1 if reverse else 0
        bu_re = bu_re.at[:, idx].add(lb_re * h0r - lb_im * h0i)
        bu_im = bu_im.at[:, idx].add(lb_re * h0i + lb_im * h0r)
    a_re = jnp.broadcast_to(lb_re, bu_re.shape)
    a_im = jnp.broadcast_to(lb_im, bu_im.shape)
    _, _, h_re, h_im = lax.associative_scan(_combine, (a_re, a_im, bu_re, bu_im), reverse=reverse, axis=1)
    return h_re, h_im


def ssm_readout(h, c_re, c_im):
    h_re, h_im = h
    return (jnp.einsum('bngp,gip->bngi', h_re, c_re.astype(jnp.float32))
            - jnp.einsum('bngp,gip->bngi', h_im, c_im.astype(jnp.float32)))


def ssm_output(u, hf, hb, cf_re, cf_im, cb_re, cb_im, d, w_glu, b_glu):
    bsz, n, _ = u.shape
    y = ssm_readout(hf, cf_re, cf_im) + ssm_readout(hb, cb_re, cb_im)
    y = y.reshape(bsz, n, SSM_W) + d.astype(jnp.float32) * u.astype(jnp.float32)
    y = jax.nn.gelu(y).astype(u.dtype)
    return y * jax.nn.sigmoid(y @ w_glu + b_glu)


def route(h, w_router, b_router):
    t = h.shape[0]
    s = jax.nn.sigmoid(h.astype(jnp.float32) @ w_router.astype(jnp.float32))
    sel = (s + b_router.astype(jnp.float32)).reshape(t, N_EXPERT_GROUPS, EXPERTS_PER_GROUP)
    gscore = lax.top_k(sel, 2)[0].sum(-1)
    gidx = jnp.argmax(gscore, axis=-1)
    gmask = (gidx[:, None] == jnp.arange(N_EXPERT_GROUPS))[:, :, None]
    masked = jnp.where(gmask, sel, -jnp.inf).reshape(t, N_EXPERTS)
    _, eidx = lax.top_k(masked, TOP_K)
    w = jnp.take_along_axis(s, eidx, axis=-1)
    w = w / jnp.sum(w, axis=-1, keepdims=True)
    return eidx, w


def moe(h, eidx, gate, w_gate, w_up, w_down):
    t, d = h.shape
    a = t * TOP_K
    e_flat = eidx.reshape(a)
    tok = jnp.repeat(jnp.arange(t), TOP_K)
    g_flat = gate.reshape(a)
    order = jnp.argsort(e_flat)
    e_s = e_flat[order]
    tok_s = tok[order]
    g_s = g_flat[order]
    counts = jnp.bincount(e_flat, length=N_EXPERTS)
    offs = jnp.cumsum(counts) - counts
    padded = (counts + ROUTE_BLOCK - 1) // ROUTE_BLOCK * ROUTE_BLOCK
    pend = jnp.cumsum(padded)
    pstart = pend - padded
    dest = pstart[e_s] + (jnp.arange(a) - offs[e_s])
    rows = (a + ROUTE_BLOCK - 1) // ROUTE_BLOCK * ROUTE_BLOCK + N_EXPERTS * ROUTE_BLOCK
    nb = rows // ROUTE_BLOCK
    buf = jnp.zeros((rows, d), h.dtype).at[dest].set(h[tok_s])
    blk_e = jnp.minimum(jnp.searchsorted(pend, jnp.arange(nb) * ROUTE_BLOCK, side='right'), N_EXPERTS - 1)

    def expert_block(args):
        xb, e = args
        hid = jax.nn.silu(xb @ w_gate[e]) * (xb @ w_up[e])
        return hid @ w_down[e]

    out = lax.map(expert_block, (buf.reshape(nb, ROUTE_BLOCK, d), blk_e)).reshape(rows, d)
    y = out[dest] * g_s[:, None].astype(out.dtype)
    return jnp.zeros_like(h).at[tok_s].add(y)


def setup_inputs(seed: int = 0) -> dict:
    key = jax.random.key(seed)
    ks = jax.random.split(key, 32)
    nrm = lambda k, shape, s: jax.random.normal(k, shape, jnp.float32) * s
    D = D_MODEL
    G, P, I = SSM_GROUPS, SSM_STATE, SSM_GROUP
    a_im_init = jnp.broadcast_to(math.pi * jnp.arange(P, dtype=jnp.float32), (DEPTH, 2, G, P))
    return {
        "x": nrm(ks[0], (BATCH, SEQ, D), 1.0),
        "c": nrm(ks[1], (BATCH, D), 1.0),
        "ctx": nrm(ks[2], (BATCH, CTX_LEN, D), 1.0),
        "c_ctx": nrm(ks[3], (D,), 1.0),
        "w_mod": nrm(ks[4], (DEPTH, D, N_MOD * D), 0.5 * D ** -0.5),
        "b_mod": nrm(ks[5], (DEPTH, N_MOD * D), 0.02),
        "g_mix": 1.0 + nrm(ks[6], (DEPTH, D), 0.02),
        "g_ffn": 1.0 + nrm(ks[7], (DEPTH, D), 0.02),
        "w_in": nrm(ks[8], (DEPTH, D, MIX_W), D ** -0.5),
        "w_out": nrm(ks[9], (DEPTH, MIX_W, D), MIX_W ** -0.5),
        "w_pool": nrm(ks[10], (DEPTH, POOL_GROUPS, POOL_GW, POOL_GW), POOL_GW ** -0.5),
        "s_pool": 1.0 + nrm(ks[11], (DEPTH, POOL_W), 0.02),
        "ssm_a_re": -0.5 + nrm(ks[12], (DEPTH, 2, G, P), 0.01),
        "ssm_a_im": a_im_init + nrm(ks[13], (DEPTH, 2, G, P), 0.01),
        "ssm_log_dt": jax.random.uniform(ks[14], (DEPTH, 2, G), jnp.float32, math.log(DT_MIN), math.log(DT_MAX)),
        "ssm_b_re": nrm(ks[15], (DEPTH, 2, G, P, I), (2 * I) ** -0.5),
        "ssm_b_im": nrm(ks[16], (DEPTH, 2, G, P, I), (2 * I) ** -0.5),
        "ssm_c_re": nrm(ks[17], (DEPTH, 2, G, I, P), (2 * P) ** -0.5),
        "ssm_c_im": nrm(ks[18], (DEPTH, 2, G, I, P), (2 * P) ** -0.5),
        "ssm_d": nrm(ks[19], (DEPTH, SSM_W), 1.0),
        "w_glu": nrm(ks[20], (DEPTH, SSM_W, SSM_W), SSM_W ** -0.5),
        "b_glu": nrm(ks[21], (DEPTH, SSM_W), 0.02),
        "w_router": nrm(ks[22], (D, N_EXPERTS), D ** -0.5),
        "b_router": nrm(ks[23], (N_EXPERTS,), 0.01),
        "w_gate": nrm(ks[24], (DEPTH, N_EXPERTS, D, D_EXPERT), D ** -0.5),
        "w_up": nrm(ks[25], (DEPTH, N_EXPERTS, D, D_EXPERT), D ** -0.5),
        "w_down": nrm(ks[26], (DEPTH, N_EXPERTS, D_EXPERT, D), D_EXPERT ** -0.5),
        "g_final": 1.0 + nrm(ks[27], (D,), 0.02),
    }


def reference(x, c, ctx, c_ctx, w_mod, b_mod, g_mix, g_ffn, w_in, w_out, w_pool, s_pool,
              ssm_a_re, ssm_a_im, ssm_log_dt, ssm_b_re, ssm_b_im, ssm_c_re, ssm_c_im, ssm_d,
              w_glu, b_glu, w_router, b_router, w_gate, w_up, w_down, g_final):
    bsz, seq_len, d = x.shape
    ctx_len = ctx.shape[1]
    ROWS = seq_len // GRID_W
    cx = ctx
    for l in range(DEPTH):
        last = l == DEPTH - 1
        mod_x = (jax.nn.silu(c) @ w_mod[l] + b_mod[l])[:, None, :]
        mod_c = jax.nn.silu(c_ctx) @ w_mod[l] + b_mod[l]
        x_sh1, x_sc1, x_g1, x_sh2, x_sc2, x_g2 = jnp.split(mod_x, N_MOD, axis=-1)
        c_sh1, c_sc1, c_g1, c_sh2, c_sc2, c_g2 = jnp.split(mod_c, N_MOD, axis=-1)

        hx = modulate(rmsnorm(x, g_mix[l]), x_sh1, x_sc1)
        hc = modulate(rmsnorm(cx, g_mix[l]), c_sh1, c_sc1)
        ux = hx @ w_in[l]
        uc = hc @ (w_in[l][:, POOL_W:] if last else w_in[l])
        ux_ssm = ux[..., POOL_W:]
        uc_ssm = uc[..., -SSM_W:]
        disc_f = ssm_discretise(ssm_a_re[l, 0], ssm_a_im[l, 0], ssm_log_dt[l, 0], ssm_b_re[l, 0], ssm_b_im[l, 0])
        disc_b = ssm_discretise(ssm_a_re[l, 1], ssm_a_im[l, 1], ssm_log_dt[l, 1], ssm_b_re[l, 1], ssm_b_im[l, 1])
        hcf = ssm_scan(uc_ssm, disc_f, None, False)
        hcb = ssm_scan(uc_ssm, disc_b, None, True)
        hxf = ssm_scan(ux_ssm, disc_f, (hcf[0][:, -1], hcf[1][:, -1]), False)
        hxb = ssm_scan(ux_ssm, disc_b, (hcb[0][:, 0], hcb[1][:, 0]), True)
        ssm_x = ssm_output(ux_ssm, hxf, hxb, ssm_c_re[l, 0], ssm_c_im[l, 0], ssm_c_re[l, 1], ssm_c_im[l, 1],
                           ssm_d[l], w_glu[l], b_glu[l])
        pool_x = pool_mixer(ux[..., :POOL_W].reshape(bsz, ROWS, GRID_W, POOL_W), w_pool[l], s_pool[l])
        pool_x = pool_x.reshape(bsz, seq_len, POOL_W)
        x = x + x_g1 * (jnp.concatenate([pool_x, ssm_x], axis=-1) @ w_out[l])
        if not last:
            ssm_cc = ssm_output(uc_ssm, hcf, hcb, ssm_c_re[l, 0], ssm_c_im[l, 0], ssm_c_re[l, 1], ssm_c_im[l, 1],
                                ssm_d[l], w_glu[l], b_glu[l])
            pool_cc = pool_mixer(uc[..., :POOL_W], w_pool[l], s_pool[l])
            cx = cx + c_g1 * (jnp.concatenate([pool_cc, ssm_cc], axis=-1) @ w_out[l])

        hx2 = modulate(rmsnorm(x, g_ffn[l]), x_sh2, x_sc2).reshape(bsz * seq_len, d)
        if last:
            tokens = hx2
        else:
            hc2 = modulate(rmsnorm(cx, g_ffn[l]), c_sh2, c_sc2).reshape(bsz * ctx_len, d)
            tokens = jnp.concatenate([hx2, hc2], axis=0)
        eidx, gate = route(tokens, w_router, b_router)
        y = moe(tokens, eidx, gate, w_gate[l], w_up[l], w_down[l])
        x = x + x_g2 * y[:bsz * seq_len].reshape(bsz, seq_len, d)
        if not last:
            cx = cx + c_g2 * y[bsz * seq_len:].reshape(bsz, ctx_len, d)
    return rmsnorm(x, g_final)
```

```cpp
#include <hip/hip_runtime.h>
#include <hip/hip_bf16.h>
#include <hip/hip_cooperative_groups.h>
#include <cstdio>
namespace cg = cooperative_groups;

#ifndef ONE_LAUNCH
#define ONE_LAUNCH 0
#endif

typedef unsigned short bf16_t;
using bf16x8 = __attribute__((ext_vector_type(8))) short;
using f32x4 = __attribute__((ext_vector_type(4))) float;

constexpr int D = 1024;
constexpr int SEQ = 16384;
constexpr int CTXL = 256;
constexpr int ROWS = SEQ + CTXL;
constexpr int NE = 32;
constexpr int DE = 512;
constexpr int NCH = ROWS / 64;
constexpr int NXCH = SEQ / 64;
constexpr int NTHREADS = 512;
constexpr int LDS_BYTES = 112 * 1024;

enum { I_X = 0, I_C, I_CTX, I_CCTX, I_WMOD, I_BMOD, I_GMIX, I_GFFN, I_WIN, I_WOUT, I_WPOOL, I_SPOOL,
       I_ARE, I_AIM, I_LOGDT, I_BRE, I_BIM, I_CRE, I_CIM, I_SSMD, I_WGLU, I_BGLU, I_WROUTER, I_BROUTER,
       I_WGATE, I_WUP, I_WDOWN, I_GFINAL };

constexpr size_t WS_W1T = 0;
constexpr size_t WS_W2T = WS_W1T + (size_t)2 * 32 * 1024 * 1024 * 2;
constexpr size_t WS_WINT = WS_W2T + (size_t)2 * 32 * 1024 * 512 * 2;
constexpr size_t WS_WOUTT = WS_WINT + (size_t)2 * 1024 * 1024 * 2;
constexpr size_t WS_WGLUT = WS_WOUTT + (size_t)2 * 1024 * 1024 * 2;
constexpr size_t WS_WPOOLT = WS_WGLUT + (size_t)2 * 512 * 512 * 2;
constexpr size_t WS_TTAB = WS_WPOOLT + (size_t)2 * 4 * 128 * 128 * 2;
constexpr size_t WS_BT1 = WS_TTAB + (size_t)2 * 32 * 128 * 256 * 2;
constexpr size_t WS_VT = WS_BT1 + (size_t)2 * 32 * 256 * 1024 * 2;
constexpr size_t WS_LAMT = WS_VT + (size_t)2 * 32 * 1024 * 256 * 2;
constexpr size_t WS_MOD = WS_LAMT + (size_t)2 * 2 * 32 * 64 * 2 * 4;
constexpr size_t WS_XCUR = WS_MOD + (size_t)2 * 2 * 6144 * 4;
constexpr size_t WS_HA = WS_XCUR + (size_t)ROWS * 1024 * 4;
constexpr size_t WS_UX = WS_HA + (size_t)ROWS * 1024 * 2;
constexpr size_t WS_PD = WS_UX + (size_t)ROWS * 1024 * 2;
constexpr size_t WS_YSM = WS_PD + (size_t)ROWS * 512 * 2;
constexpr size_t WS_MIX = WS_YSM + (size_t)ROWS * 512 * 2;
constexpr size_t WS_L = WS_MIX + (size_t)ROWS * 1024 * 2;
constexpr size_t WS_HIN = WS_L + (size_t)NCH * 32 * 256 * 4;
constexpr size_t WS_CNT = WS_HIN + (size_t)NCH * 32 * 256 * 2;
constexpr size_t WS_TOKLIST = WS_CNT + 1024;
constexpr size_t WS_TOKINFO = WS_TOKLIST + (size_t)32 * ROWS * 4;
constexpr size_t WS_TOKW = WS_TOKINFO + (size_t)ROWS * 4 * 4;
constexpr size_t WS_END = WS_TOKW + (size_t)ROWS * 2 * 4;

struct Params {
    const float* in[28];
    float* out;
    unsigned char* ws;
};

__device__ __forceinline__ unsigned short f2bf(float f) {
    unsigned u = __float_as_uint(f);
    u += 0x7FFFu + ((u >> 16) & 1u);
    return (unsigned short)(u >> 16);
}
__device__ __forceinline__ float bf2f(unsigned short h) { return __uint_as_float(((unsigned)h) << 16); }
__device__ __forceinline__ unsigned pack2(float a, float b) { return (unsigned)f2bf(a) | ((unsigned)f2bf(b) << 16); }
__device__ __forceinline__ float sigmoidf_fast(float z) { return 1.f / (1.f + __expf(-z)); }
__device__ __forceinline__ float gelu_tanh(float x) {
    const float k0 = 0.7978845608028654f, k1 = 0.044715f;
    float u = k0 * (x + k1 * x * x * x);
    float t = 1.f - 2.f / (__expf(2.f * u) + 1.f);
    return 0.5f * x * (1.f + t);
}
__device__ __forceinline__ float wave_sum(float v) {
#pragma unroll
    for (int m = 32; m >= 1; m >>= 1) v += __shfl_xor(v, m, 64);
    return v;
}
__device__ __forceinline__ void cpow(float lm, float th, int e, float& re, float& im) {
    float mag = expf(lm * (float)e);
    float ang = th * (float)e;
    const float inv2pi = 0.15915494309189535f;
    float k = rintf(ang * inv2pi);
    float r = fmaf(-k, 6.2831854820251465f, ang);
    r = fmaf(-k, -1.7484556000744883e-07f, r);
    float s, c;
    sincosf(r, &s, &c);
    re = mag * c; im = mag * s;
}
__device__ __forceinline__ void glds16(const void* g, void* l) {
    __builtin_amdgcn_global_load_lds((const unsigned*)g, (unsigned*)l, 16, 0, 0);
}

template <class ARow>
__device__ __forceinline__ void gemm_tile(f32x4 (&acc)[4][4], ARow arow, const bf16_t* __restrict__ Bt, int ldb, int K, char* smem, const int tid) {
    const int lane = tid & 63, wid = tid >> 6, wr = wid >> 1, wc = wid & 1, fr = lane & 15, fq = lane >> 4;
    char* sA = smem;
    char* sB = smem + 16384;
    const int rA = tid >> 2, cA = (tid & 3) * 8;
    const bf16_t* a0 = arow(rA) + cA;
    const bf16_t* a1 = arow(rA + 128) + cA;
    const bf16_t* b0 = Bt + (size_t)rA * ldb + cA;
#pragma unroll
    for (int m = 0; m < 4; ++m)
#pragma unroll
        for (int n = 0; n < 4; ++n) acc[m][n] = f32x4{0.f, 0.f, 0.f, 0.f};
#pragma unroll 1
    for (int kt = 0; kt < K; kt += 32) {
        glds16(a0 + kt, sA + tid * 16);
        glds16(a1 + kt, sA + 8192 + tid * 16);
        glds16(b0 + kt, sB + tid * 16);
        asm volatile("s_waitcnt vmcnt(0)" ::: "memory");
        __syncthreads();
        bf16x8 af[4], bfr[4];
#pragma unroll
        for (int m = 0; m < 4; ++m) af[m] = *reinterpret_cast<const bf16x8*>(sA + (wr * 64 + m * 16 + fr) * 64 + fq * 16);
#pragma unroll
        for (int n = 0; n < 4; ++n) bfr[n] = *reinterpret_cast<const bf16x8*>(sB + (wc * 64 + n * 16 + fr) * 64 + fq * 16);
#pragma unroll
        for (int m = 0; m < 4; ++m)
#pragma unroll
            for (int n = 0; n < 4; ++n) acc[m][n] = __builtin_amdgcn_mfma_f32_16x16x32_bf16(bfr[n], af[m], acc[m][n], 0, 0, 0);
        __syncthreads();
    }
}

__device__ __forceinline__ void pro_gemv(const Params& p, int item, char* smem, const int tid) {
    const int l = item / 96, n0 = (item % 96) * 64;
    const int ks = tid >> 6, col = tid & 63;
    const float* wm = p.in[I_WMOD] + (size_t)l * 1024 * 6144;
    const float* cv = p.in[I_C];
    const float* cc = p.in[I_CCTX];
    float ax = 0.f, ac = 0.f;
#pragma unroll 8
    for (int k = ks * 128; k < ks * 128 + 128; ++k) {
        float w = wm[(size_t)k * 6144 + n0 + col];
        float a = cv[k], b = cc[k];
        float sa = a / (1.f + expf(-a)), sb = b / (1.f + expf(-b));
        ax = fmaf(sa, w, ax);
        ac = fmaf(sb, w, ac);
    }
    float* red = reinterpret_cast<float*>(smem);
    __syncthreads();
    red[(0 * 8 + ks) * 64 + col] = ax;
    red[(1 * 8 + ks) * 64 + col] = ac;
    __syncthreads();
    if (tid < 128) {
        int v = tid >> 6, c = tid & 63;
        float s = p.in[I_BMOD][l * 6144 + n0 + c];
        for (int k = 0; k < 8; ++k) s += red[(v * 8 + k) * 64 + c];
        float* mod = reinterpret_cast<float*>(p.ws + WS_MOD);
        mod[(l * 2 + v) * 6144 + n0 + c] = s;
    }
    __syncthreads();
}

__device__ __forceinline__ void pro_ssm(const Params& p, int item, char* smem, const int tid) {
    const int lg = item / 6, sub = item % 6, l = lg >> 5, g = lg & 31;
    float* sLm = reinterpret_cast<float*>(smem);
    float* sTh = sLm + 128;
    float* sBb = sTh + 128;
    float* sC = sBb + 2 * 64 * 16 * 2;
    float* sPw = sC + 2 * 16 * 64 * 2;
    __syncthreads();
    if (tid < 128) {
        const int d = tid >> 6, pp = tid & 63;
        const int idx = ((l * 2 + d) * 32 + g) * 64 + pp;
        float are = fminf(p.in[I_ARE][idx], -1e-4f);
        float aim = p.in[I_AIM][idx];
        float dt = expf(p.in[I_LOGDT][(l * 2 + d) * 32 + g]);
        float lm = are * dt, th = aim * dt;
        sLm[tid] = lm; sTh[tid] = th;
        float lr, li;
        cpow(lm, th, 1, lr, li);
        float nr = lr - 1.f, ni = li;
        float den = are * are + aim * aim;
        float kr = (nr * are + ni * aim) / den;
        float ki = (ni * are - nr * aim) / den;
        for (int j = 0; j < 16; ++j) {
            float br = p.in[I_BRE][(size_t)idx * 16 + j], bi = p.in[I_BIM][(size_t)idx * 16 + j];
            sBb[((d * 64 + pp) * 16 + j) * 2 + 0] = kr * br - ki * bi;
            sBb[((d * 64 + pp) * 16 + j) * 2 + 1] = kr * bi + ki * br;
        }
        for (int i = 0; i < 16; ++i) {
            size_t ci = ((size_t)((l * 2 + d) * 32 + g) * 16 + i) * 64 + pp;
            sC[((d * 16 + i) * 64 + pp) * 2 + 0] = p.in[I_CRE][ci];
            sC[((d * 16 + i) * 64 + pp) * 2 + 1] = p.in[I_CIM][ci];
        }
    }
    __syncthreads();
    if (sub < 4) {
        bf16_t* tt = reinterpret_cast<bf16_t*>(p.ws + WS_TTAB) + (size_t)lg * 128 * 256;
        const int slot = tid >> 8, ij = tid & 255, i = ij >> 4, j = ij & 15;
        for (int base = sub * 32; base < sub * 32 + 32; base += 2) {
            __syncthreads();
            if (tid < 128) {
                int s2 = tid >> 6, pp = tid & 63;
                int di = base + s2;
                int dl = di - 63;
                int d = dl > 0 ? 0 : 1;
                int e = dl > 0 ? dl : -dl;
                float re, im;
                cpow(sLm[d * 64 + pp], sTh[d * 64 + pp], e, re, im);
                sPw[(s2 * 64 + pp) * 2 + 0] = re;
                sPw[(s2 * 64 + pp) * 2 + 1] = im;
            }
            __syncthreads();
            const int di = base + slot;
            if (di < 127) {
                const int dl = di - 63;
                float accv = 0.f;
                if (dl != 0) {
                    const int d = dl > 0 ? 0 : 1;
                    for (int pp = 0; pp < 64; ++pp) {
                        float cr = sC[((d * 16 + i) * 64 + pp) * 2], ci = sC[((d * 16 + i) * 64 + pp) * 2 + 1];
                        float pr = sPw[(slot * 64 + pp) * 2], pi = sPw[(slot * 64 + pp) * 2 + 1];
                        float br = sBb[((d * 64 + pp) * 16 + j) * 2], bi = sBb[((d * 64 + pp) * 16 + j) * 2 + 1];
                        float xr = cr * pr - ci * pi, xi = cr * pi + ci * pr;
                        accv += xr * br - xi * bi;
                    }
                } else {
                    for (int d = 0; d < 2; ++d)
                        for (int pp = 0; pp < 64; ++pp) {
                            float cr = sC[((d * 16 + i) * 64 + pp) * 2], ci = sC[((d * 16 + i) * 64 + pp) * 2 + 1];
                            float br = sBb[((d * 64 + pp) * 16 + j) * 2], bi = sBb[((d * 64 + pp) * 16 + j) * 2 + 1];
                            accv += cr * br - ci * bi;
                        }
                    if (i == j) accv += p.in[I_SSMD][l * 512 + g * 16 + i];
                }
                tt[(size_t)di * 256 + i * 16 + j] = f2bf(accv);
            }
        }
    } else if (sub == 4) {
        bf16_t* bt = reinterpret_cast<bf16_t*>(p.ws + WS_BT1) + (size_t)lg * 256 * 1024;
        for (int task = tid; task < 128 * 64; task += NTHREADS) {
            const int s = task & 63, dp = task >> 6, d = dp >> 6, pp = dp & 63;
            const int e = d == 0 ? 63 - s : s;
            float pr, pi;
            cpow(sLm[dp], sTh[dp], e, pr, pi);
            unsigned re8[8], im8[8];
#pragma unroll
            for (int j2 = 0; j2 < 8; ++j2) {
                float b0r = sBb[(dp * 16 + 2 * j2) * 2], b0i = sBb[(dp * 16 + 2 * j2) * 2 + 1];
                float b1r = sBb[(dp * 16 + 2 * j2 + 1) * 2], b1i = sBb[(dp * 16 + 2 * j2 + 1) * 2 + 1];
                re8[j2] = pack2(pr * b0r - pi * b0i, pr * b1r - pi * b1i);
                im8[j2] = pack2(pr * b0i + pi * b0r, pr * b1i + pi * b1r);
            }
            uint4* dre = reinterpret_cast<uint4*>(bt + (size_t)(d * 128 + pp) * 1024 + s * 16);
            uint4* dim_ = reinterpret_cast<uint4*>(bt + (size_t)(d * 128 + 64 + pp) * 1024 + s * 16);
            dre[0] = make_uint4(re8[0], re8[1], re8[2], re8[3]);
            dre[1] = make_uint4(re8[4], re8[5], re8[6], re8[7]);
            dim_[0] = make_uint4(im8[0], im8[1], im8[2], im8[3]);
            dim_[1] = make_uint4(im8[4], im8[5], im8[6], im8[7]);
        }
    } else {
        bf16_t* vt = reinterpret_cast<bf16_t*>(p.ws + WS_VT) + (size_t)lg * 1024 * 256;
        for (int task = tid; task < 64 * 128; task += NTHREADS) {
            const int dp = task & 127, t = task >> 7, d = dp >> 6, pp = dp & 63;
            const int e = d == 0 ? t + 1 : 64 - t;
            float pr, pi;
            cpow(sLm[dp], sTh[dp], e, pr, pi);
            for (int i = 0; i < 16; ++i) {
                float cr = sC[((d * 16 + i) * 64 + pp) * 2], ci = sC[((d * 16 + i) * 64 + pp) * 2 + 1];
                float xr = cr * pr - ci * pi, xi = cr * pi + ci * pr;
                vt[(size_t)(t * 16 + i) * 256 + d * 128 + pp] = f2bf(xr);
                vt[(size_t)(t * 16 + i) * 256 + d * 128 + 64 + pp] = f2bf(-xi);
            }
        }
        if (tid < 128) {
            float re, im;
            cpow(sLm[tid], sTh[tid], 64, re, im);
            const int d = tid >> 6, pp = tid & 63;
            float* lt = reinterpret_cast<float*>(p.ws + WS_LAMT);
            lt[(((l * 2 + d) * 32 + g) * 64 + pp) * 2 + 0] = re;
            lt[(((l * 2 + d) * 32 + g) * 64 + pp) * 2 + 1] = im;
        }
    }
    __syncthreads();
}

__device__ __forceinline__ void pro_convert_tile(const float* __restrict__ src, int K, int N, bf16_t* __restrict__ dst, int k0, int n0, int mapmode, char* smem, const int tid) {
    float* t = reinterpret_cast<float*>(smem);
    __syncthreads();
    {
        const int r = tid >> 3, c = (tid & 7) * 8;
        const float4* s4 = reinterpret_cast<const float4*>(src + (size_t)(k0 + r) * N + n0 + c);
        float4 v0 = s4[0], v1 = s4[1];
        float* tr = t + r * 65 + c;
        tr[0] = v0.x; tr[1] = v0.y; tr[2] = v0.z; tr[3] = v0.w;
        tr[4] = v1.x; tr[5] = v1.y; tr[6] = v1.z; tr[7] = v1.w;
    }
    __syncthreads();
    {
        const int n = tid >> 3, kc = (tid & 7) * 8;
        unsigned o[4];
#pragma unroll
        for (int i = 0; i < 4; ++i) o[i] = pack2(t[(kc + 2 * i) * 65 + n], t[(kc + 2 * i + 1) * 65 + n]);
        int ng = n0 + n;
        int nd = ng;
        if (mapmode == 1) nd = (ng >> 4) * 32 + (ng & 15);
        else if (mapmode == 2) nd = (ng >> 4) * 32 + 16 + (ng & 15);
        *reinterpret_cast<uint4*>(dst + (size_t)nd * K + k0 + kc) = make_uint4(o[0], o[1], o[2], o[3]);
    }
}

__device__ __forceinline__ void pro_convert(const Params& p, int tile, char* smem, const int tid) {
    const float* src; bf16_t* dst; int K, N, mode = 0, t;
    if (tile < 8192) {
        int m = tile >> 7; t = tile & 127; K = 1024; N = 512; mode = 1;
        src = p.in[I_WGATE] + (size_t)m * 1024 * 512; dst = reinterpret_cast<bf16_t*>(p.ws + WS_W1T) + (size_t)m * 1024 * 1024;
    } else if (tile < 16384) {
        int u = tile - 8192; int m = u >> 7; t = u & 127; K = 1024; N = 512; mode = 2;
        src = p.in[I_WUP] + (size_t)m * 1024 * 512; dst = reinterpret_cast<bf16_t*>(p.ws + WS_W1T) + (size_t)m * 1024 * 1024;
    } else if (tile < 24576) {
        int u = tile - 16384; int m = u >> 7; t = u & 127; K = 512; N = 1024;
        src = p.in[I_WDOWN] + (size_t)m * 512 * 1024; dst = reinterpret_cast<bf16_t*>(p.ws + WS_W2T) + (size_t)m * 1024 * 512;
    } else if (tile < 25088) {
        int u = tile - 24576; int m = u >> 8; t = u & 255; K = 1024; N = 1024;
        src = p.in[I_WIN] + (size_t)m * 1024 * 1024; dst = reinterpret_cast<bf16_t*>(p.ws + WS_WINT) + (size_t)m * 1024 * 1024;
    } else if (tile < 25600) {
        int u = tile - 25088; int m = u >> 8; t = u & 255; K = 1024; N = 1024;
        src = p.in[I_WOUT] + (size_t)m * 1024 * 1024; dst = reinterpret_cast<bf16_t*>(p.ws + WS_WOUTT) + (size_t)m * 1024 * 1024;
    } else if (tile < 25728) {
        int u = tile - 25600; int m = u >> 6; t = u & 63; K = 512; N = 512;
        src = p.in[I_WGLU] + (size_t)m * 512 * 512; dst = reinterpret_cast<bf16_t*>(p.ws + WS_WGLUT) + (size_t)m * 512 * 512;
    } else {
        int u = tile - 25728; int m = u >> 2; t = u & 3; K = 128; N = 128;
        src = p.in[I_WPOOL] + (size_t)m * 128 * 128; dst = reinterpret_cast<bf16_t*>(p.ws + WS_WPOOLT) + (size_t)m * 128 * 128;
    }
    const int ntn = N / 64;
    const int kt = t / ntn, nt = t % ntn;
    pro_convert_tile(src, K, N, dst, kt * 64, nt * 64, mode, smem, tid);
}

__device__ __forceinline__ void phase_prologue(const Params& p, int bid, int nb, char* smem, const int tid) {
    if (bid == 0 && tid < 64) reinterpret_cast<int*>(p.ws + WS_CNT)[tid] = 0;
    constexpr int N_GEMV = 192, N_SSM = 2 * 32 * 6, N_CONV = 25760;
    for (int it = bid; it < N_GEMV + N_SSM + N_CONV; it += nb) {
        if (it < N_GEMV) pro_gemv(p, it, smem, tid);
        else if (it < N_GEMV + N_SSM) pro_ssm(p, it - N_GEMV, smem, tid);
        else pro_convert(p, it - N_GEMV - N_SSM, smem, tid);
    }
}

__device__ __forceinline__ const float* mod_ptr(const Params& p, int l, int v, int which) {
    return reinterpret_cast<const float*>(p.ws + WS_MOD) + (l * 2 + v) * 6144 + which * 1024;
}

__device__ __forceinline__ void phase_norm0(const Params& p, int bid, int nb, const int tid) {
    const int lane = tid & 63, wid = tid >> 6;
    bf16_t* hA = reinterpret_cast<bf16_t*>(p.ws + WS_HA);
    const float* gm = p.in[I_GMIX];
    for (int r = bid * 8 + wid; r < ROWS; r += nb * 8) {
        const int v = r < SEQ ? 0 : 1;
        const float* src = v == 0 ? p.in[I_X] + (size_t)r * 1024 : p.in[I_CTX] + (size_t)(r - SEQ) * 1024;
        const float* sh = mod_ptr(p, 0, v, 0);
        const float* sc = mod_ptr(p, 0, v, 1);
        float4 xv[4];
        float ss = 0.f;
#pragma unroll
        for (int i = 0; i < 4; ++i) {
            xv[i] = *reinterpret_cast<const float4*>(src + i * 256 + lane * 4);
            ss += xv[i].x * xv[i].x + xv[i].y * xv[i].y + xv[i].z * xv[i].z + xv[i].w * xv[i].w;
        }
        ss = wave_sum(ss);
        const float rstd = rsqrtf(ss * (1.f / 1024.f) + 1e-6f);
#pragma unroll
        for (int i = 0; i < 4; ++i) {
            const int k = i * 256 + lane * 4;
            float4 g = *reinterpret_cast<const float4*>(gm + k);
            float4 a = *reinterpret_cast<const float4*>(sc + k);
            float4 b = *reinterpret_cast<const float4*>(sh + k);
            float o0 = xv[i].x * rstd * g.x * (1.f + a.x) + b.x;
            float o1 = xv[i].y * rstd * g.y * (1.f + a.y) + b.y;
            float o2 = xv[i].z * rstd * g.z * (1.f + a.z) + b.z;
            float o3 = xv[i].w * rstd * g.w * (1.f + a.w) + b.w;
            *reinterpret_cast<uint2*>(hA + (size_t)r * 1024 + k) = make_uint2(pack2(o0, o1), pack2(o2, o3));
        }
    }
}

__device__ __forceinline__ void phase_win(const Params& p, int l, int bid, int nb, char* smem, const int tid) {
    const bf16_t* hA = reinterpret_cast<const bf16_t*>(p.ws + WS_HA);
    const bf16_t* wt = reinterpret_cast<const bf16_t*>(p.ws + WS_WINT) + (size_t)l * 1024 * 1024;
    bf16_t* ux = reinterpret_cast<bf16_t*>(p.ws + WS_UX);
    const int lane = tid & 63, wid = tid >> 6, wr = wid >> 1, wc = wid & 1, fr = lane & 15, fq = lane >> 4;
    const int ntiles = (ROWS / 256) * 8;
    for (int tile = bid; tile < ntiles; tile += nb) {
        const int mt = tile >> 3, nt = tile & 7;
        f32x4 acc[4][4];
        const bf16_t* abase = hA + (size_t)mt * 256 * 1024;
        gemm_tile(acc, [&](int r) { return abase + (size_t)r * 1024; }, wt + (size_t)nt * 128 * 1024, 1024, 1024, smem, tid);
#pragma unroll
        for (int m = 0; m < 4; ++m)
#pragma unroll
            for (int n = 0; n < 4; ++n) {
                const int row = mt * 256 + wr * 64 + m * 16 + fr, col = nt * 128 + wc * 64 + n * 16 + fq * 4;
                *reinterpret_cast<uint2*>(ux + (size_t)row * 1024 + col) = make_uint2(pack2(acc[m][n][0], acc[m][n][1]), pack2(acc[m][n][2], acc[m][n][3]));
            }
    }
}

__device__ __forceinline__ void ssm_load_u(const Params& p, int g, int c0, int nvalid, char* sU, const int tid) {
    const bf16_t* ux = reinterpret_cast<const bf16_t*>(p.ws + WS_UX);
    for (int pc = tid; pc < 2048; pc += NTHREADS) {
        const int half = pc & 1, s = (pc >> 1) & 63, cc = pc >> 7;
        const int c = c0 + (cc < nvalid ? cc : nvalid - 1);
        uint4 v = *reinterpret_cast<const uint4*>(ux + (size_t)(c * 64 + s) * 1024 + 512 + g * 16 + half * 8);
        *reinterpret_cast<uint4*>(sU + cc * 2064 + s * 32 + half * 16) = v;
    }
}

__device__ __forceinline__ void phase_p1_pdiff(const Params& p, int l, int bid, int nb, char* smem, const int tid) {
    const int lane = tid & 63, wid = tid >> 6, fr = lane & 15, fq = lane >> 4;
    const bool last = (l == 1);
    const int nP1 = 32 * 17;
    for (int it = bid; it < nP1; it += nb) {
        const int g = it / 17, mt = it % 17;
        const int c0 = mt * 16, nvalid = mt < 16 ? 16 : 4;
        __syncthreads();
        ssm_load_u(p, g, c0, nvalid, smem, tid);
        __syncthreads();
        const bf16_t* bt = reinterpret_cast<const bf16_t*>(p.ws + WS_BT1) + (size_t)(l * 32 + g) * 256 * 1024;
        f32x4 acc[2] = {f32x4{0, 0, 0, 0}, f32x4{0, 0, 0, 0}};
#pragma unroll 2
        for (int ks = 0; ks < 32; ++ks) {
            bf16x8 a = *reinterpret_cast<const bf16x8*>(smem + fr * 2064 + ks * 64 + fq * 16);
#pragma unroll
            for (int nn = 0; nn < 2; ++nn) {
                bf16x8 b = *reinterpret_cast<const bf16x8*>(bt + (size_t)(wid * 32 + nn * 16 + fr) * 1024 + ks * 32 + fq * 8);
                acc[nn] = __builtin_amdgcn_mfma_f32_16x16x32_bf16(b, a, acc[nn], 0, 0, 0);
            }
        }
        if (fr < nvalid) {
            float* L = reinterpret_cast<float*>(p.ws + WS_L);
#pragma unroll
            for (int nn = 0; nn < 2; ++nn)
                *reinterpret_cast<float4*>(L + ((size_t)(c0 + fr) * 32 + g) * 256 + wid * 32 + nn * 16 + fq * 4) =
                    make_float4(acc[nn][0], acc[nn][1], acc[nn][2], acc[nn][3]);
        }
    }
    const bf16_t* ux = reinterpret_cast<const bf16_t*>(p.ws + WS_UX);
    bf16_t* pd = reinterpret_cast<bf16_t*>(p.ws + WS_PD);
    const int nblk = last ? SEQ / 64 : ROWS / 64;
    for (int it = bid; it < nblk; it += nb) {
        const int r0 = it * 64;
        const int seg0 = r0 < SEQ ? r0 : SEQ;
        const int segn = r0 < SEQ ? 64 : CTXL;
        const int c = tid;
        const int h = 1 << (c >> 7);
#pragma unroll 2
        for (int rr = 0; rr < 64; ++rr) {
            const int t = r0 + rr - seg0;
            const int lo = max(t - h, 0), hi = min(t + h, segn);
            float s = 0.f;
            for (int q = lo; q < hi; ++q) s += bf2f(ux[(size_t)(seg0 + q) * 1024 + c]);
            const float u = bf2f(ux[(size_t)(r0 + rr) * 1024 + c]);
            pd[(size_t)(r0 + rr) * 512 + c] = f2bf(s / (float)(hi - lo) - u);
        }
    }
}

__device__ __forceinline__ void phase_p2(const Params& p, int l, int bid, int nb, const int tid) {
    const int gt = bid * NTHREADS + tid;
    if (gt >= 4096) return;
    const int g = gt >> 7, d = (gt >> 6) & 1, pp = gt & 63;
    const float* lt = reinterpret_cast<const float*>(p.ws + WS_LAMT) + (((l * 2 + d) * 32 + g) * 64 + pp) * 2;
    const float ar = lt[0], ai = lt[1];
    const float* L = reinterpret_cast<const float*>(p.ws + WS_L);
    bf16_t* H = reinterpret_cast<bf16_t*>(p.ws + WS_HIN);
    float hr = 0.f, hi = 0.f;
#pragma unroll 4
    for (int step = 0; step < NCH; ++step) {
        int c;
        if (d == 0) c = step < 4 ? NXCH + step : step - 4;
        else c = step < 4 ? NCH - 1 - step : NXCH - 1 - (step - 4);
        const size_t idx = ((size_t)c * 32 + g) * 256 + d * 128 + pp;
        H[idx] = f2bf(hr);
        H[idx + 64] = f2bf(hi);
        const float lr = L[idx], li = L[idx + 64];
        const float nr = ar * hr - ai * hi + lr;
        const float ni = ar * hi + ai * hr + li;
        hr = nr; hi = ni;
    }
}

__device__ __forceinline__ void phase_p3_pool(const Params& p, int l, int bid, int nb, char* smem, const int tid) {
    const int lane = tid & 63, wid = tid >> 6, wr = wid >> 1, wc = wid & 1, fr = lane & 15, fq = lane >> 4;
    const bool last = (l == 1);
    const int nmt = last ? 16 : 17;
    const int nP3 = 32 * nmt;
    char* sT = smem;
    char* sU = smem + 65536;
    char* sH = smem + 65536 + 33024;
    bf16_t* ysm = reinterpret_cast<bf16_t*>(p.ws + WS_YSM);
    for (int it = bid; it < nP3; it += nb) {
        const int g = it / nmt, mt = it % nmt;
        const int c0 = mt * 16, nvalid = mt < 16 ? 16 : 4;
        __syncthreads();
        {
            const uint4* src = reinterpret_cast<const uint4*>(p.ws + WS_TTAB + (size_t)(l * 32 + g) * 128 * 512);
            for (int i = tid; i < 4064; i += NTHREADS) reinterpret_cast<uint4*>(sT)[i] = src[i];
        }
        ssm_load_u(p, g, c0, nvalid, sU, tid);
        {
            const bf16_t* H = reinterpret_cast<const bf16_t*>(p.ws + WS_HIN);
            const int cc = tid >> 5, i = tid & 31;
            const int c = c0 + (cc < nvalid ? cc : nvalid - 1);
            uint4 v = *reinterpret_cast<const uint4*>(H + ((size_t)c * 32 + g) * 256 + i * 8);
            *reinterpret_cast<uint4*>(sH + cc * 528 + i * 16) = v;
        }
        __syncthreads();
        f32x4 acc[8];
#pragma unroll
        for (int tt = 0; tt < 8; ++tt) acc[tt] = f32x4{0, 0, 0, 0};
#pragma unroll 2
        for (int ks = 0; ks < 32; ++ks) {
            bf16x8 a = *reinterpret_cast<const bf16x8*>(sU + fr * 2064 + ks * 64 + fq * 16);
            const int s = 2 * ks + (fq >> 1);
#pragma unroll
            for (int tt = 0; tt < 8; ++tt) {
                const int t = wid * 8 + tt;
                bf16x8 b = *reinterpret_cast<const bf16x8*>(sT + (t - s + 63) * 512 + fr * 32 + (fq & 1) * 16);
                acc[tt] = __builtin_amdgcn_mfma_f32_16x16x32_bf16(b, a, acc[tt], 0, 0, 0);
            }
        }
        const bf16_t* vt = reinterpret_cast<const bf16_t*>(p.ws + WS_VT) + (size_t)(l * 32 + g) * 1024 * 256;
#pragma unroll 2
        for (int ks = 0; ks < 8; ++ks) {
            bf16x8 a = *reinterpret_cast<const bf16x8*>(sH + fr * 528 + ks * 64 + fq * 16);
#pragma unroll
            for (int tt = 0; tt < 8; ++tt) {
                const int t = wid * 8 + tt;
                bf16x8 b = *reinterpret_cast<const bf16x8*>(vt + (size_t)(t * 16 + fr) * 256 + ks * 32 + fq * 8);
                acc[tt] = __builtin_amdgcn_mfma_f32_16x16x32_bf16(b, a, acc[tt], 0, 0, 0);
            }
        }
        if (fr < nvalid) {
#pragma unroll
            for (int tt = 0; tt < 8; ++tt) {
                const int row = (c0 + fr) * 64 + wid * 8 + tt;
                *reinterpret_cast<uint2*>(ysm + (size_t)row * 512 + g * 16 + fq * 4) =
                    make_uint2(pack2(gelu_tanh(acc[tt][0]), gelu_tanh(acc[tt][1])), pack2(gelu_tanh(acc[tt][2]), gelu_tanh(acc[tt][3])));
            }
        }
    }
    const bf16_t* pd = reinterpret_cast<const bf16_t*>(p.ws + WS_PD);
    bf16_t* mix = reinterpret_cast<bf16_t*>(p.ws + WS_MIX);
    const int nmtiles = last ? SEQ / 256 : ROWS / 256;
    const float* sp = p.in[I_SPOOL] + l * 512;
    for (int it = bid; it < nmtiles * 4; it += nb) {
        const int mt = it >> 2, gq = it & 3;
        __syncthreads();
        f32x4 acc[4][4];
        const bf16_t* abase = pd + (size_t)mt * 256 * 512 + gq * 128;
        gemm_tile(acc, [&](int r) { return abase + (size_t)r * 512; },
                  reinterpret_cast<const bf16_t*>(p.ws + WS_WPOOLT) + (size_t)(l * 4 + gq) * 128 * 128, 128, 128, smem, tid);
#pragma unroll
        for (int m = 0; m < 4; ++m)
#pragma unroll
            for (int n = 0; n < 4; ++n) {
                const int row = mt * 256 + wr * 64 + m * 16 + fr, col = gq * 128 + wc * 64 + n * 16 + fq * 4;
                float4 s4 = *reinterpret_cast<const float4*>(sp + col);
                *reinterpret_cast<uint2*>(mix + (size_t)row * 1024 + col) =
                    make_uint2(pack2(acc[m][n][0] * s4.x, acc[m][n][1] * s4.y), pack2(acc[m][n][2] * s4.z, acc[m][n][3] * s4.w));
            }
    }
}

__device__ __forceinline__ void phase_glu(const Params& p, int l, int bid, int nb, char* smem, const int tid) {
    const int lane = tid & 63, wid = tid >> 6, wr = wid >> 1, wc = wid & 1, fr = lane & 15, fq = lane >> 4;
    const bool last = (l == 1);
    const bf16_t* ysm = reinterpret_cast<const bf16_t*>(p.ws + WS_YSM);
    bf16_t* mix = reinterpret_cast<bf16_t*>(p.ws + WS_MIX);
    const bf16_t* wt = reinterpret_cast<const bf16_t*>(p.ws + WS_WGLUT) + (size_t)l * 512 * 512;
    const float* bg = p.in[I_BGLU] + l * 512;
    const int nmtiles = last ? SEQ / 256 : ROWS / 256;
    for (int it = bid; it < nmtiles * 4; it += nb) {
        const int mt = it >> 2, nt = it & 3;
        f32x4 acc[4][4];
        const bf16_t* abase = ysm + (size_t)mt * 256 * 512;
        gemm_tile(acc, [&](int r) { return abase + (size_t)r * 512; }, wt + (size_t)nt * 128 * 512, 512, 512, smem, tid);
#pragma unroll
        for (int m = 0; m < 4; ++m)
#pragma unroll
            for (int n = 0; n < 4; ++n) {
                const int row = mt * 256 + wr * 64 + m * 16 + fr, col = nt * 128 + wc * 64 + n * 16 + fq * 4;
                float4 b4 = *reinterpret_cast<const float4*>(bg + col);
                uint2 yv = *reinterpret_cast<const uint2*>(ysm + (size_t)row * 512 + col);
                float y0 = bf2f((unsigned short)(yv.x & 0xFFFF)), y1 = bf2f((unsigned short)(yv.x >> 16));
                float y2 = bf2f((unsigned short)(yv.y & 0xFFFF)), y3 = bf2f((unsigned short)(yv.y >> 16));
                float o0 = y0 * sigmoidf_fast(acc[m][n][0] + b4.x), o1 = y1 * sigmoidf_fast(acc[m][n][1] + b4.y);
                float o2 = y2 * sigmoidf_fast(acc[m][n][2] + b4.z), o3 = y3 * sigmoidf_fast(acc[m][n][3] + b4.w);
                *reinterpret_cast<uint2*>(mix + (size_t)row * 1024 + 512 + col) = make_uint2(pack2(o0, o1), pack2(o2, o3));
            }
    }
}

__device__ __forceinline__ void phase_wout(const Params& p, int l, int bid, int nb, char* smem, const int tid) {
    const int lane = tid & 63, wid = tid >> 6, wr = wid >> 1, wc = wid & 1, fr = lane & 15, fq = lane >> 4;
    const bool last = (l == 1);
    const bf16_t* mix = reinterpret_cast<const bf16_t*>(p.ws + WS_MIX);
    const bf16_t* wt = reinterpret_cast<const bf16_t*>(p.ws + WS_WOUTT) + (size_t)l * 1024 * 1024;
    float* xcur = reinterpret_cast<float*>(p.ws + WS_XCUR);
    const int nmtiles = last ? SEQ / 256 : ROWS / 256;
    for (int it = bid; it < nmtiles * 8; it += nb) {
        const int mt = it >> 3, nt = it & 7;
        f32x4 acc[4][4];
        const bf16_t* abase = mix + (size_t)mt * 256 * 1024;
        gemm_tile(acc, [&](int r) { return abase + (size_t)r * 1024; }, wt + (size_t)nt * 128 * 1024, 1024, 1024, smem, tid);
        const int v = mt < SEQ / 256 ? 0 : 1;
        const float* g1 = mod_ptr(p, l, v, 2);
#pragma unroll
        for (int m = 0; m < 4; ++m)
#pragma unroll
            for (int n = 0; n < 4; ++n) {
                const int row = mt * 256 + wr * 64 + m * 16 + fr, col = nt * 128 + wc * 64 + n * 16 + fq * 4;
                const float* xin;
                if (l == 0) xin = row < SEQ ? p.in[I_X] + (size_t)row * 1024 : p.in[I_CTX] + (size_t)(row - SEQ) * 1024;
                else xin = xcur + (size_t)row * 1024;
                float4 xv = *reinterpret_cast<const float4*>(xin + col);
                float4 g4 = *reinterpret_cast<const float4*>(g1 + col);
                float4 o = make_float4(xv.x + g4.x * acc[m][n][0], xv.y + g4.y * acc[m][n][1], xv.z + g4.z * acc[m][n][2], xv.w + g4.w * acc[m][n][3]);
                *reinterpret_cast<float4*>(xcur + (size_t)row * 1024 + col) = o;
            }
    }
}

__device__ __forceinline__ void phase_router(const Params& p, int l, int bid, int nb, char* smem, const int tid) {
    const int lane = tid & 63, wid = tid >> 6;
    const bool last = (l == 1);
    const int nrows = last ? SEQ : ROWS;
    const float* xcur = reinterpret_cast<const float*>(p.ws + WS_XCUR);
    bf16_t* hA = reinterpret_cast<bf16_t*>(p.ws + WS_HA);
    const float* gf = p.in[I_GFFN] + l * 1024;
    const float* wrt = p.in[I_WROUTER];
    float* hrow = reinterpret_cast<float*>(smem) + wid * 1024;
    int* cnt = reinterpret_cast<int*>(p.ws + WS_CNT) + l * 32;
    int* toklist = reinterpret_cast<int*>(p.ws + WS_TOKLIST);
    int* tokinfo = reinterpret_cast<int*>(p.ws + WS_TOKINFO);
    float* tokw = reinterpret_cast<float*>(p.ws + WS_TOKW);
    const int e = lane & 31, kh = lane >> 5;
    const float brt = p.in[I_BROUTER][e];
    for (int r = bid * 8 + wid; r < nrows; r += nb * 8) {
        const int v = r < SEQ ? 0 : 1;
        const float* sh = mod_ptr(p, l, v, 3);
        const float* sc = mod_ptr(p, l, v, 4);
        const float* src = xcur + (size_t)r * 1024;
        float4 xv[4];
        float ss = 0.f;
#pragma unroll
        for (int i = 0; i < 4; ++i) {
            xv[i] = *reinterpret_cast<const float4*>(src + i * 256 + lane * 4);
            ss += xv[i].x * xv[i].x + xv[i].y * xv[i].y + xv[i].z * xv[i].z + xv[i].w * xv[i].w;
        }
        ss = wave_sum(ss);
        const float rstd = rsqrtf(ss * (1.f / 1024.f) + 1e-6f);
#pragma unroll
        for (int i = 0; i < 4; ++i) {
            const int k = i * 256 + lane * 4;
            float4 g = *reinterpret_cast<const float4*>(gf + k);
            float4 a = *reinterpret_cast<const float4*>(sc + k);
            float4 b = *reinterpret_cast<const float4*>(sh + k);
            float o0 = xv[i].x * rstd * g.x * (1.f + a.x) + b.x;
            float o1 = xv[i].y * rstd * g.y * (1.f + a.y) + b.y;
            float o2 = xv[i].z * rstd * g.z * (1.f + a.z) + b.z;
            float o3 = xv[i].w * rstd * g.w * (1.f + a.w) + b.w;
            *reinterpret_cast<uint2*>(hA + (size_t)r * 1024 + k) = make_uint2(pack2(o0, o1), pack2(o2, o3));
            *reinterpret_cast<float4*>(hrow + k) = make_float4(o0, o1, o2, o3);
        }
        float acc = 0.f;
#pragma unroll 4
        for (int k = kh * 512; k < kh * 512 + 512; k += 4) {
            float4 h4 = *reinterpret_cast<const float4*>(hrow + k);
            acc = fmaf(h4.x, wrt[(k + 0) * 32 + e], acc);
            acc = fmaf(h4.y, wrt[(k + 1) * 32 + e], acc);
            acc = fmaf(h4.z, wrt[(k + 2) * 32 + e], acc);
            acc = fmaf(h4.w, wrt[(k + 3) * 32 + e], acc);
        }
        acc += __shfl_xor(acc, 32, 64);
        const float s = 1.f / (1.f + expf(-acc));
        const float sel = s + brt;
        float sv[32], sl[32];
#pragma unroll
        for (int i = 0; i < 32; ++i) { sv[i] = __shfl(s, i, 64); sl[i] = __shfl(sel, i, 64); }
        int bestg = 0; float bestv = -1e30f;
#pragma unroll
        for (int gq = 0; gq < 4; ++gq) {
            float m1 = -1e30f, m2 = -1e30f;
#pragma unroll
            for (int i = 0; i < 8; ++i) {
                float x = sl[gq * 8 + i];
                if (x > m1) { m2 = m1; m1 = x; } else if (x > m2) m2 = x;
            }
            float gs = m1 + m2;
            if (gs > bestv) { bestv = gs; bestg = gq; }
        }
        int e0 = 0, e1 = 0; float v0 = -1e30f, v1 = -1e30f, s0 = 0.f, s1 = 0.f;
#pragma unroll
        for (int i = 0; i < 32; ++i) {
            if ((i >> 3) == bestg) {
                float x = sl[i];
                if (x > v0) { v1 = v0; e1 = e0; s1 = s0; v0 = x; e0 = i; s0 = sv[i]; }
                else if (x > v1) { v1 = x; e1 = i; s1 = sv[i]; }
            }
        }
        if (lane == 0) {
            const int p0 = atomicAdd(&cnt[e0], 1);
            const int p1 = atomicAdd(&cnt[e1], 1);
            toklist[e0 * ROWS + p0] = r;
            toklist[e1 * ROWS + p1] = r;
            tokinfo[r * 4 + 0] = e0; tokinfo[r * 4 + 1] = p0; tokinfo[r * 4 + 2] = e1; tokinfo[r * 4 + 3] = p1;
            const float inv = 1.f / (s0 + s1);
            tokw[r * 2 + 0] = s0 * inv; tokw[r * 2 + 1] = s1 * inv;
        }
    }
}

__device__ __forceinline__ void moe_prefix(const Params& p, int l, int* sm, const int tid) {
    __syncthreads();
    if (tid == 0) {
        const int* cnt = reinterpret_cast<const int*>(p.ws + WS_CNT) + l * 32;
        int ro = 0, ts = 0;
        for (int e = 0; e < 32; ++e) {
            sm[e] = ro; sm[33 + e] = ts;
            const int c = cnt[e];
            ro += c; ts += (c + 255) >> 8;
        }
        sm[32] = ro; sm[65] = ts;
    }
    __syncthreads();
}

__device__ __forceinline__ void phase_moe1(const Params& p, int l, int bid, int nb, char* smem, const int tid) {
    const int lane = tid & 63, wid = tid >> 6, wr = wid >> 1, wc = wid & 1, fr = lane & 15, fq = lane >> 4;
    int* sm = reinterpret_cast<int*>(smem + 24576);
    moe_prefix(p, l, sm, tid);
    const int* cnt = reinterpret_cast<const int*>(p.ws + WS_CNT) + l * 32;
    const int* toklist = reinterpret_cast<const int*>(p.ws + WS_TOKLIST);
    const bf16_t* hA = reinterpret_cast<const bf16_t*>(p.ws + WS_HA);
    bf16_t* hid = reinterpret_cast<bf16_t*>(p.ws + WS_UX);
    const int ntiles = sm[65] * 8;
    for (int it = bid; it < ntiles; it += nb) {
        const int tm = it >> 3, nt = it & 7;
        int e = 0;
        while (sm[33 + e + 1] <= tm) ++e;
        const int mt = tm - sm[33 + e];
        const int ce = cnt[e], roff = sm[e];
        const int* tl = toklist + e * ROWS;
        f32x4 acc[4][4];
        gemm_tile(acc, [&](int r) { int rr = mt * 256 + r; rr = rr < ce ? rr : ce - 1; return hA + (size_t)tl[rr] * 1024; },
                  reinterpret_cast<const bf16_t*>(p.ws + WS_W1T) + ((size_t)(l * 32 + e) * 1024 + nt * 128) * 1024, 1024, 1024, smem, tid);
#pragma unroll
        for (int m = 0; m < 4; ++m) {
            const int rloc = mt * 256 + wr * 64 + m * 16 + fr;
            if (rloc < ce) {
#pragma unroll
                for (int pr = 0; pr < 2; ++pr) {
                    float o[4];
#pragma unroll
                    for (int j = 0; j < 4; ++j) {
                        const float gte = acc[m][2 * pr][j], up = acc[m][2 * pr + 1][j];
                        o[j] = gte * sigmoidf_fast(gte) * up;
                    }
                    const int hcol = nt * 64 + wc * 32 + pr * 16 + fq * 4;
                    *reinterpret_cast<uint2*>(hid + (size_t)(roff + rloc) * 512 + hcol) = make_uint2(pack2(o[0], o[1]), pack2(o[2], o[3]));
                }
            }
        }
    }
}

__device__ __forceinline__ void phase_moe2(const Params& p, int l, int bid, int nb, char* smem, const int tid) {
    const int lane = tid & 63, wid = tid >> 6, wr = wid >> 1, wc = wid & 1, fr = lane & 15, fq = lane >> 4;
    int* sm = reinterpret_cast<int*>(smem + 24576);
    moe_prefix(p, l, sm, tid);
    const int* cnt = reinterpret_cast<const int*>(p.ws + WS_CNT) + l * 32;
    const bf16_t* hid = reinterpret_cast<const bf16_t*>(p.ws + WS_UX);
    bf16_t* ybuf = reinterpret_cast<bf16_t*>(p.ws + WS_PD);
    const int ntiles = sm[65] * 8;
    for (int it = bid; it < ntiles; it += nb) {
        const int tm = it >> 3, nt = it & 7;
        int e = 0;
        while (sm[33 + e + 1] <= tm) ++e;
        const int mt = tm - sm[33 + e];
        const int ce = cnt[e], roff = sm[e];
        f32x4 acc[4][4];
        gemm_tile(acc, [&](int r) { int rr = mt * 256 + r; rr = rr < ce ? rr : ce - 1; return hid + (size_t)(roff + rr) * 512; },
                  reinterpret_cast<const bf16_t*>(p.ws + WS_W2T) + ((size_t)(l * 32 + e) * 1024 + nt * 128) * 512, 512, 512, smem, tid);
#pragma unroll
        for (int m = 0; m < 4; ++m) {
            const int rloc = mt * 256 + wr * 64 + m * 16 + fr;
            if (rloc < ce) {
#pragma unroll
                for (int n = 0; n < 4; ++n) {
                    const int col = nt * 128 + wc * 64 + n * 16 + fq * 4;
                    *reinterpret_cast<uint2*>(ybuf + (size_t)(roff + rloc) * 1024 + col) =
                        make_uint2(pack2(acc[m][n][0], acc[m][n][1]), pack2(acc[m][n][2], acc[m][n][3]));
                }
            }
        }
    }
}

__device__ __forceinline__ void phase_combine(const Params& p, int l, int bid, int nb, char* smem, const int tid) {
    const int lane = tid & 63, wid = tid >> 6;
    const bool last = (l == 1);
    int* sm = reinterpret_cast<int*>(smem);
    moe_prefix(p, l, sm, tid);
    const int nrows = last ? SEQ : ROWS;
    float* xcur = reinterpret_cast<float*>(p.ws + WS_XCUR);
    const bf16_t* ybuf = reinterpret_cast<const bf16_t*>(p.ws + WS_PD);
    bf16_t* hA = reinterpret_cast<bf16_t*>(p.ws + WS_HA);
    const int* tokinfo = reinterpret_cast<const int*>(p.ws + WS_TOKINFO);
    const float* tokw = reinterpret_cast<const float*>(p.ws + WS_TOKW);
    for (int r = bid * 8 + wid; r < nrows; r += nb * 8) {
        const int v = r < SEQ ? 0 : 1;
        const float* g2 = mod_ptr(p, l, v, 5);
        const int4 ti = *reinterpret_cast<const int4*>(tokinfo + r * 4);
        const float w0 = tokw[r * 2], w1 = tokw[r * 2 + 1];
        const bf16_t* y0 = ybuf + (size_t)(sm[ti.x] + ti.y) * 1024;
        const bf16_t* y1 = ybuf + (size_t)(sm[ti.z] + ti.w) * 1024;
        float4 xv[4];
        float ss = 0.f;
#pragma unroll
        for (int i = 0; i < 4; ++i) {
            const int k = i * 256 + lane * 4;
            xv[i] = *reinterpret_cast<const float4*>(xcur + (size_t)r * 1024 + k);
            uint2 a = *reinterpret_cast<const uint2*>(y0 + k);
            uint2 b = *reinterpret_cast<const uint2*>(y1 + k);
            float4 g = *reinterpret_cast<const float4*>(g2 + k);
            xv[i].x += g.x * (w0 * bf2f((unsigned short)(a.x & 0xFFFF)) + w1 * bf2f((unsigned short)(b.x & 0xFFFF)));
            xv[i].y += g.y * (w0 * bf2f((unsigned short)(a.x >> 16)) + w1 * bf2f((unsigned short)(b.x >> 16)));
            xv[i].z += g.z * (w0 * bf2f((unsigned short)(a.y & 0xFFFF)) + w1 * bf2f((unsigned short)(b.y & 0xFFFF)));
            xv[i].w += g.w * (w0 * bf2f((unsigned short)(a.y >> 16)) + w1 * bf2f((unsigned short)(b.y >> 16)));
            ss += xv[i].x * xv[i].x + xv[i].y * xv[i].y + xv[i].z * xv[i].z + xv[i].w * xv[i].w;
        }
        ss = wave_sum(ss);
        const float rstd = rsqrtf(ss * (1.f / 1024.f) + 1e-6f);
        if (!last) {
            const float* gm = p.in[I_GMIX] + 1024;
            const float* sh = mod_ptr(p, 1, v, 0);
            const float* sc = mod_ptr(p, 1, v, 1);
#pragma unroll
            for (int i = 0; i < 4; ++i) {
                const int k = i * 256 + lane * 4;
                *reinterpret_cast<float4*>(xcur + (size_t)r * 1024 + k) = xv[i];
                float4 g = *reinterpret_cast<const float4*>(gm + k);
                float4 a = *reinterpret_cast<const float4*>(sc + k);
                float4 b = *reinterpret_cast<const float4*>(sh + k);
                float o0 = xv[i].x * rstd * g.x * (1.f + a.x) + b.x;
                float o1 = xv[i].y * rstd * g.y * (1.f + a.y) + b.y;
                float o2 = xv[i].z * rstd * g.z * (1.f + a.z) + b.z;
                float o3 = xv[i].w * rstd * g.w * (1.f + a.w) + b.w;
                *reinterpret_cast<uint2*>(hA + (size_t)r * 1024 + k) = make_uint2(pack2(o0, o1), pack2(o2, o3));
            }
        } else {
            const float* gfin = p.in[I_GFINAL];
#pragma unroll
            for (int i = 0; i < 4; ++i) {
                const int k = i * 256 + lane * 4;
                float4 g = *reinterpret_cast<const float4*>(gfin + k);
                *reinterpret_cast<float4*>(p.out + (size_t)r * 1024 + k) =
                    make_float4(xv[i].x * rstd * g.x, xv[i].y * rstd * g.y, xv[i].z * rstd * g.z, xv[i].w * rstd * g.w);
            }
        }
    }
}

constexpr int N_PHASES = 22;
__device__ __forceinline__ void run_phase(const Params& p, int ph, int bid, int nb, char* smem, const int tid) {
    if (ph == 0) { phase_prologue(p, bid, nb, smem, tid); return; }
    if (ph == 1) { phase_norm0(p, bid, nb, tid); return; }
    const int l = (ph - 2) / 10, q = (ph - 2) % 10;
    switch (q) {
        case 0: phase_win(p, l, bid, nb, smem, tid); break;
        case 1: phase_p1_pdiff(p, l, bid, nb, smem, tid); break;
        case 2: phase_p2(p, l, bid, nb, tid); break;
        case 3: phase_p3_pool(p, l, bid, nb, smem, tid); break;
        case 4: phase_glu(p, l, bid, nb, smem, tid); break;
        case 5: phase_wout(p, l, bid, nb, smem, tid); break;
        case 6: phase_router(p, l, bid, nb, smem, tid); break;
        case 7: phase_moe1(p, l, bid, nb, smem, tid); break;
        case 8: phase_moe2(p, l, bid, nb, smem, tid); break;
        default: phase_combine(p, l, bid, nb, smem, tid); break;
    }
}

__global__ void __launch_bounds__(NTHREADS, 2) fwd_kernel(Params p, int ph_lo, int ph_hi) {
    extern __shared__ __attribute__((aligned(16))) char smem[];
    for (int ph = ph_lo; ph < ph_hi; ++ph) {
        Params q = p;
        asm volatile("" : "+s"(q.ws));
        asm volatile("" : "+s"(q.out));
        int tid = threadIdx.x;
        asm volatile("" : "+v"(tid));
        int bid = blockIdx.x;
        asm volatile("" : "+s"(bid));
        run_phase(q, ph, bid, gridDim.x, smem, tid);
        if (ph + 1 < ph_hi) {
            cg::this_grid().sync();
        }
    }
}

extern "C" void kernel_launch(void* const* d_in, const int* in_sizes, int n_in, void* d_out, int out_size, void* d_ws, size_t ws_size,
                              hipStream_t stream) {
    if (ws_size < WS_END) { fprintf(stderr, "kernel_launch: workspace too small: %zu < %zu\n", ws_size, (size_t)WS_END); return; }
    static int inited = 0;
    static int grid = 256;
    if (!inited) {
        inited = 1;
        hipFuncSetAttribute((const void*)fwd_kernel, hipFuncAttributeMaxDynamicSharedMemorySize, LDS_BYTES);
        int dev = 0, cus = 0, per_cu = 0;
        hipGetDevice(&dev);
        hipDeviceGetAttribute(&cus, hipDeviceAttributeMultiprocessorCount, dev);
        hipOccupancyMaxActiveBlocksPerMultiprocessor(&per_cu, (const void*)fwd_kernel, NTHREADS, LDS_BYTES);
        if (per_cu < 1) per_cu = 1;
        grid = cus;
        (void)hipGetLastError();
    }
    Params p{};
    for (int i = 0; i < 28; ++i) p.in[i] = (const float*)d_in[i];
    p.out = (float*)d_out;
    p.ws = (unsigned char*)d_ws;
#if ONE_LAUNCH
    int lo = 0, hi = N_PHASES;
    void* args[] = {&p, &lo, &hi};
    hipError_t e = hipLaunchCooperativeKernel((const void*)fwd_kernel, dim3(grid), dim3(NTHREADS), args, LDS_BYTES, stream);
    if (e != hipSuccess) fprintf(stderr, "cooperative launch failed: %s (grid %d)\n", hipGetErrorString(e), grid);
#else
    for (int ph = 0; ph < N_PHASES; ++ph) {
        hipLaunchKernelGGL(fwd_kernel, dim3(grid), dim3(NTHREADS), LDS_BYTES, stream, p, ph, ph + 1);
    }
#endif
}
```

```cpp
#include <hip/hip_runtime.h>
#include <hip/hip_bf16.h>
#include <hip/hip_cooperative_groups.h>
#include <cstdio>
#include <type_traits>
namespace cg = cooperative_groups;

#ifndef REP_MASK
#define REP_MASK 0u
#endif
#ifndef PRO_PART
#define PRO_PART 7
#endif
#ifndef ONE_LAUNCH
#define ONE_LAUNCH 1
#endif

#define LAS __attribute__((address_space(3)))
typedef unsigned short bf16_t;
using bf16x8 = __attribute__((ext_vector_type(8))) short;
using f32x4 = __attribute__((ext_vector_type(4))) float;
using u32x4 = __attribute__((ext_vector_type(4))) unsigned;
using i32x4 = __attribute__((ext_vector_type(4))) int;
using i32x8 = __attribute__((ext_vector_type(8))) int;
using f32x2 = __attribute__((ext_vector_type(2))) float;

constexpr int D = 1024;
constexpr int SEQ = 16384;
constexpr int CTXL = 256;
constexpr int ROWS = SEQ + CTXL;
constexpr int NE = 32;
constexpr int DE = 512;
constexpr int NCH = ROWS / 64;
constexpr int NXCH = SEQ / 64;
constexpr int NTHREADS = 512;
constexpr int LDS_BYTES = 146 * 1024;
constexpr int LDS_SM_OFF = 131072;

enum { I_X = 0, I_C, I_CTX, I_CCTX, I_WMOD, I_BMOD, I_GMIX, I_GFFN, I_WIN, I_WOUT, I_WPOOL, I_SPOOL,
       I_ARE, I_AIM, I_LOGDT, I_BRE, I_BIM, I_CRE, I_CIM, I_SSMD, I_WGLU, I_BGLU, I_WROUTER, I_BROUTER,
       I_WGATE, I_WUP, I_WDOWN, I_GFINAL };

constexpr size_t WS_W1T = 0;
constexpr size_t WS_W2T = WS_W1T + (size_t)2 * 32 * 1024 * 1024 * 2;
constexpr size_t WS_WINT = WS_W2T + (size_t)2 * 32 * 1024 * 512 * 2;
constexpr size_t WS_WOUTT = WS_WINT + (size_t)2 * 1024 * 1024 * 2;
constexpr size_t WS_WGLUT = WS_WOUTT + (size_t)2 * 1024 * 1024 * 2;
constexpr size_t WS_WPOOLT = WS_WGLUT + (size_t)2 * 512 * 512 * 2;
constexpr size_t WS_TTAB = WS_WPOOLT + (size_t)2 * 4 * 128 * 128 * 2;
constexpr size_t WS_BT1 = WS_TTAB + (size_t)2 * 32 * 128 * 256 * 2;
constexpr size_t WS_VT = WS_BT1 + (size_t)2 * 32 * 256 * 1024 * 2;
constexpr size_t WS_LAMT = WS_VT + (size_t)2 * 32 * 1024 * 256 * 2;
constexpr size_t WS_MOD = WS_LAMT + (size_t)2 * 2 * 32 * 64 * 2 * 4;
constexpr size_t WS_XCUR = WS_MOD + (size_t)2 * 2 * 6144 * 4;
constexpr size_t WS_HA = WS_XCUR + (size_t)ROWS * 1024 * 4;
constexpr size_t WS_UX = WS_HA + (size_t)ROWS * 1024 * 2;
constexpr size_t WS_PD = WS_UX + (size_t)ROWS * 1024 * 2;
constexpr size_t WS_YSM = WS_PD + (size_t)ROWS * 512 * 2;
constexpr size_t WS_MIX = WS_YSM + (size_t)ROWS * 512 * 2;
constexpr size_t WS_L = WS_MIX + (size_t)ROWS * 1024 * 2;
constexpr size_t WS_HIN = WS_L + (size_t)NCH * 32 * 256 * 4;
constexpr size_t WS_CNT = WS_HIN + (size_t)NCH * 32 * 256 * 2;
constexpr int CNT_STRIDE = 64;
constexpr int SUBCAP = ROWS / 8;
constexpr size_t WS_TOKLIST = WS_CNT + (size_t)2 * 8 * 32 * CNT_STRIDE * 4;
constexpr size_t WS_TOKINFO = WS_TOKLIST + (size_t)32 * ROWS * 4;
constexpr size_t WS_TOKW = WS_TOKINFO + (size_t)ROWS * 4 * 4;
constexpr size_t WS_WPRIME = WS_TOKW + (size_t)ROWS * 2 * 4;
constexpr size_t WS_GP = WS_WPRIME + (size_t)4 * 1024 * 32 * 4;
constexpr size_t WS_RB = WS_GP + (size_t)4 * 1024 * 4;
constexpr size_t WS_EAGG = WS_RB + 1024;
constexpr size_t WS_ECTX = WS_EAGG + (size_t)32 * 8 * 256 * 4;
constexpr size_t WS_MODP = WS_ECTX + (size_t)32 * 256 * 4;
constexpr size_t WS_BAR = WS_MODP + (size_t)2 * 16 * 2 * 6144 * 4;
constexpr size_t WS_GCNT = WS_BAR + 14336;
constexpr size_t WS_MQ = WS_BAR + 16384;
constexpr size_t WS_MDEP = WS_BAR + 20480;
constexpr size_t WS_CTL_BYTES = 65536;
constexpr size_t WS_END = WS_BAR + WS_CTL_BYTES;

struct Params {
    const float* in[28];
    float* out;
    unsigned char* ws;
};

__device__ __forceinline__ unsigned pack2(float a, float b) {
    unsigned r;
    asm("v_cvt_pk_bf16_f32 %0, %1, %2" : "=v"(r) : "v"(a), "v"(b));
    return r;
}
__device__ __forceinline__ unsigned short f2bf(float f) { return (unsigned short)(pack2(f, 0.f) & 0xFFFFu); }
__device__ __forceinline__ float bf2f(unsigned short h) { return __uint_as_float(((unsigned)h) << 16); }
__device__ __forceinline__ float sigmoidf_fast(float z) { return __builtin_amdgcn_rcpf(1.f + __builtin_amdgcn_exp2f(-1.4426950408889634f * z)); }
__device__ __forceinline__ float gelu_tanh(float x) {
    const float c2 = -2.f * 0.7978845608028654f * 1.4426950408889634f, k1 = 0.044715f;
    const float w = x * fmaf(k1 * x, x, 1.f);
    return x * __builtin_amdgcn_rcpf(1.f + __builtin_amdgcn_exp2f(c2 * w));
}
__device__ __forceinline__ float wave_sum(float v) {
#pragma unroll
    for (int m = 32; m >= 1; m >>= 1) v += __shfl_xor(v, m, 64);
    return v;
}
__device__ __forceinline__ void cpow(float lm, float th, int e, float& re, float& im) {
    float mag = expf(lm * (float)e);
    float ang = th * (float)e;
    const float inv2pi = 0.15915494309189535f;
    float k = rintf(ang * inv2pi);
    float r = fmaf(-k, 6.2831854820251465f, ang);
    r = fmaf(-k, -1.7484556000744883e-07f, r);
    float s, c;
    sincosf(r, &s, &c);
    re = mag * c; im = mag * s;
}
__device__ __forceinline__ void glds16(const void* g, void* l) {
    __builtin_amdgcn_global_load_lds((const unsigned*)g, (unsigned*)l, 16, 0, 0);
}

template <class ARow>
__device__ __forceinline__ void gemm_tile(f32x4 (&acc)[4][4], ARow arow, const bf16_t* __restrict__ Bt, int ldb, int K, char* smem, const int tid) {
    const int lane = tid & 63, wid = tid >> 6, wr = wid >> 1, wc = wid & 1, fr = lane & 15, fq = lane >> 4;
    char* sA = smem;
    char* sB = smem + 16384;
    const int rA = tid >> 2, cA = (tid & 3) * 8;
    const bf16_t* a0 = arow(rA) + cA;
    const bf16_t* a1 = arow(rA + 128) + cA;
    const bf16_t* b0 = Bt + (size_t)rA * ldb + cA;
#pragma unroll
    for (int m = 0; m < 4; ++m)
#pragma unroll
        for (int n = 0; n < 4; ++n) acc[m][n] = f32x4{0.f, 0.f, 0.f, 0.f};
#pragma unroll 1
    for (int kt = 0; kt < K; kt += 32) {
        glds16(a0 + kt, sA + tid * 16);
        glds16(a1 + kt, sA + 8192 + tid * 16);
        glds16(b0 + kt, sB + tid * 16);
        asm volatile("s_waitcnt vmcnt(0)" ::: "memory");
        __syncthreads();
        bf16x8 af[4], bfr[4];
#pragma unroll
        for (int m = 0; m < 4; ++m) af[m] = *reinterpret_cast<const bf16x8*>(sA + (wr * 64 + m * 16 + fr) * 64 + fq * 16);
#pragma unroll
        for (int n = 0; n < 4; ++n) bfr[n] = *reinterpret_cast<const bf16x8*>(sB + (wc * 64 + n * 16 + fr) * 64 + fq * 16);
#pragma unroll
        for (int m = 0; m < 4; ++m)
#pragma unroll
            for (int n = 0; n < 4; ++n) acc[m][n] = __builtin_amdgcn_mfma_f32_16x16x32_bf16(bfr[n], af[m], acc[m][n], 0, 0, 0);
        __syncthreads();
    }
}


__device__ __forceinline__ int lds_byte(int r, int c) {
    int st = (r >> 4) * 2 + (c >> 5), rr = r & 15, cc = c & 31, ob = rr * 64 + cc * 2;
    return st * 1024 + (ob ^ (((ob >> 9) & 1) << 5));
}
__device__ __forceinline__ void stage_rc(int b, int& R, int& C) {
    int st = b / 1024, sb = b % 1024, swz = sb ^ (((sb >> 9) & 1) << 5);
    R = (st >> 1) * 16 + swz / 64; C = (st & 1) * 32 + (swz % 64) / 2;
}
#define G2_SA(b, h) (((b) * 2 + (h)) * 16384)
#define G2_SB(b, h) ((4 + (b) * 2 + (h)) * 16384)
#define G2_STAGE_A(b, h, kt) do { const char* _u = cA + (size_t)(kt) * 128; asm volatile("" : "+s"(_u)); _Pragma("unroll") for (int _i = 0; _i < 2; ++_i) \
    __builtin_amdgcn_global_load_lds((const unsigned*)(_u + voA[h][_i]), (LAS unsigned*)(lds + G2_SA(b, h) + ldsw + _i * 8192), 16, 0, 0); } while (0)
#define G2_STAGE_B(b, h, kt) do { const char* _u = cB + (size_t)(kt) * 128 + (size_t)(h) * hstepB; asm volatile("" : "+s"(_u)); _Pragma("unroll") for (int _i = 0; _i < 2; ++_i) \
    __builtin_amdgcn_global_load_lds((const unsigned*)(_u + voB[_i]), (LAS unsigned*)(lds + G2_SB(b, h) + ldsw + _i * 8192), 16, 0, 0); } while (0)
#define G2_LDA(dst, b, h) do { _Pragma("unroll") for (int m = 0; m < 4; ++m) \
    dst[m] = g2_cat(*(const LAS i32x4*)(lds + G2_SA(b, h) + aoffk[0] + m * 2048), *(const LAS i32x4*)(lds + G2_SA(b, h) + aoffk[1] + m * 2048)); } while (0)
#define G2_LDB(dst, b, h) do { _Pragma("unroll") for (int n = 0; n < 2; ++n) \
    dst[n] = g2_cat(*(const LAS i32x4*)(lds + G2_SB(b, h) + boffk[0] + n * 2048), *(const LAS i32x4*)(lds + G2_SB(b, h) + boffk[1] + n * 2048)); } while (0)
#define G2_MMA(ai, bj, At_, Bt_) do { { __builtin_amdgcn_s_setprio(1); \
    _Pragma("unroll") for (int m = 0; m < 4; ++m) _Pragma("unroll") for (int n = 0; n < 2; ++n) { \
      if constexpr (FP8) { \
        asm volatile("v_mfma_scale_f32_16x16x128_f8f6f4 %0, %1, %2, %0, %3, %4 op_sel_hi:[0,0,0]" \
                     : "+v"(acc[ai][bj][m][n]) : "v"(Bt_[n]), "v"(At_[m]), "v"(sc_w), "v"(sc_a)); \
      } else { \
        acc[ai][bj][m][n] = __builtin_amdgcn_mfma_f32_16x16x32_bf16(g2_lo(Bt_[n]), g2_lo(At_[m]), acc[ai][bj][m][n], 0, 0, 0); \
        acc[ai][bj][m][n] = __builtin_amdgcn_mfma_f32_16x16x32_bf16(g2_hi(Bt_[n]), g2_hi(At_[m]), acc[ai][bj][m][n], 0, 0, 0); \
      } } \
    __builtin_amdgcn_s_setprio(0); } } while (0)
#define G2_WAIT_V(n) asm volatile("s_waitcnt vmcnt(" #n ")" ::: "memory")
#define G2_WAIT_L(n) asm volatile("s_waitcnt lgkmcnt(" #n ")" ::: "memory")
#define G2_BAR __builtin_amdgcn_s_barrier()
#define G2_SCHED __builtin_amdgcn_sched_barrier(0)

__device__ __forceinline__ size_t uniform_off(size_t v) {
    const unsigned lo = __builtin_amdgcn_readfirstlane((unsigned)v), hi = __builtin_amdgcn_readfirstlane((unsigned)(v >> 32));
    return ((size_t)hi << 32) | lo;
}
constexpr int FP8_WSCALE = 0x79797979;
__device__ __forceinline__ i32x8 g2_cat(i32x4 a, i32x4 b) { return __builtin_shufflevector(a, b, 0, 1, 2, 3, 4, 5, 6, 7); }
__device__ __forceinline__ bf16x8 g2_lo(i32x8 v) { return __builtin_bit_cast(bf16x8, (i32x4)__builtin_shufflevector(v, v, 0, 1, 2, 3)); }
__device__ __forceinline__ bf16x8 g2_hi(i32x8 v) { return __builtin_bit_cast(bf16x8, (i32x4)__builtin_shufflevector(v, v, 4, 5, 6, 7)); }
template <bool FP8, class AOff>
__device__ __forceinline__ int gemm256(f32x4 (&acc)[2][2][4][2], const unsigned char* __restrict__ wsb, size_t aoff0, AOff aoffb, size_t boff0, int ldbB, int Kbytes,
                                        char* smem, const int tid, const int nvalid = 256) {
    LAS unsigned char* lds = (LAS unsigned char*)smem;
    const int lane = tid & 63, wid = __builtin_amdgcn_readfirstlane(tid >> 6), wr = wid >> 2, wc = wid & 3, fr = lane & 15, fq = lane >> 4;
    unsigned voA[2][2], voB[2];
#pragma unroll
    for (int i = 0; i < 2; ++i) {
        int R, C;
        stage_rc(tid * 16 + i * 8192, R, C);
        voA[0][i] = (unsigned)aoffb(R) + (unsigned)C * 2u;
        voA[1][i] = (unsigned)aoffb(128 + R) + (unsigned)C * 2u;
        voB[i] = (unsigned)(R * ldbB) + (unsigned)C * 2u;
    }
    const char* cA = reinterpret_cast<const char*>(wsb) + uniform_off(aoff0);
    const char* cB = reinterpret_cast<const char*>(wsb) + uniform_off(boff0);
    const size_t hstepB = (size_t)128 * ldbB;
    const unsigned ldsw = (unsigned)wid * 1024u;
    const int aoffk[2] = { lds_byte(wr * 64 + fr, FP8 ? fq * 16 : fq * 8), lds_byte(wr * 64 + fr, FP8 ? fq * 16 + 8 : 32 + fq * 8) };
    const int boffk[2] = { lds_byte(wc * 32 + fr, FP8 ? fq * 16 : fq * 8), lds_byte(wc * 32 + fr, FP8 ? fq * 16 + 8 : 32 + fq * 8) };
    (void)nvalid;
#pragma unroll
    for (int a = 0; a < 2; ++a)
#pragma unroll
        for (int b = 0; b < 2; ++b)
#pragma unroll
            for (int m = 0; m < 4; ++m)
#pragma unroll
                for (int n = 0; n < 2; ++n) acc[a][b][m][n] = f32x4{0.f, 0.f, 0.f, 0.f};
    i32x8 At[4], B0[2], B1[2];
    const int sc_w = FP8_WSCALE, sc_a = 0x7F7F7F7F;
    (void)sc_w; (void)sc_a;
    const int nt = Kbytes / 128;
    G2_STAGE_B(0, 0, 0); G2_STAGE_A(0, 0, 0);
    G2_STAGE_B(0, 1, 0); G2_STAGE_A(0, 1, 0);
    if (wr == 1) G2_BAR;
    G2_WAIT_V(4); G2_BAR;
    G2_STAGE_B(1, 0, 1); G2_STAGE_A(1, 0, 1); G2_STAGE_B(1, 1, 1);
    G2_WAIT_V(6); G2_BAR;
#pragma unroll 1
    for (int t = 0; t < nt - 2; t += 2) {
        G2_LDB(B0, 0, 0); G2_SCHED; G2_LDA(At, 0, 0); G2_STAGE_A(1, 1, t + 1);
        G2_WAIT_L(8); G2_BAR; G2_WAIT_L(0); G2_MMA(0, 0, At, B0); G2_BAR; G2_SCHED;
        G2_LDB(B1, 0, 1); G2_STAGE_B(0, 0, t + 2);
        G2_BAR; G2_WAIT_L(0); G2_MMA(0, 1, At, B1); G2_BAR;
        G2_LDA(At, 0, 1); G2_STAGE_A(0, 0, t + 2);
        G2_BAR; G2_WAIT_L(0); G2_MMA(1, 0, At, B0); G2_BAR; G2_SCHED;
        G2_STAGE_B(0, 1, t + 2);
        G2_WAIT_V(6); G2_BAR; G2_MMA(1, 1, At, B1); G2_BAR;
        G2_LDB(B0, 1, 0); G2_SCHED; G2_LDA(At, 1, 0); G2_STAGE_A(0, 1, t + 2);
        G2_WAIT_L(8); G2_BAR; G2_WAIT_L(0); G2_MMA(0, 0, At, B0); G2_BAR; G2_SCHED;
        G2_LDB(B1, 1, 1); G2_STAGE_B(1, 0, t + 3);
        G2_BAR; G2_WAIT_L(0); G2_MMA(0, 1, At, B1); G2_BAR;
        G2_LDA(At, 1, 1); G2_STAGE_A(1, 0, t + 3);
        G2_BAR; G2_WAIT_L(0); G2_MMA(1, 0, At, B0); G2_BAR; G2_SCHED;
        G2_STAGE_B(1, 1, t + 3);
        G2_WAIT_V(6); G2_BAR; G2_MMA(1, 1, At, B1); G2_BAR;
    }
    { G2_LDB(B0, 0, 0); G2_LDA(At, 0, 0); G2_STAGE_A(1, 1, nt - 1);
      G2_BAR; G2_WAIT_L(0); G2_MMA(0, 0, At, B0); G2_BAR;
      G2_LDB(B1, 0, 1); G2_BAR; G2_WAIT_L(0); G2_MMA(0, 1, At, B1); G2_BAR;
      G2_LDA(At, 0, 1); G2_WAIT_V(4); G2_BAR; G2_WAIT_L(0); G2_MMA(1, 0, At, B0); G2_MMA(1, 1, At, B1); G2_BAR; }
    { G2_LDB(B0, 1, 0); G2_LDA(At, 1, 0); G2_WAIT_V(2); G2_BAR; G2_WAIT_L(0); G2_MMA(0, 0, At, B0); G2_BAR;
      G2_LDB(B1, 1, 1); G2_WAIT_V(0); G2_BAR; G2_WAIT_L(0); G2_MMA(0, 1, At, B1); G2_BAR;
      G2_LDA(At, 1, 1); G2_BAR; G2_WAIT_L(0); G2_MMA(1, 0, At, B0); G2_MMA(1, 1, At, B1); G2_BAR; }
    if (wr == 0) G2_BAR;
    if constexpr (FP8) asm volatile("s_nop 15\n\ts_nop 15" ::: "memory");
    int etid = tid;
    asm volatile("" : "+v"(etid));
    return etid;
}

template <class ValFn, class RowPtrFn>
__device__ __forceinline__ void store_tile_bf16(char* smem, const int et, ValFn val, RowPtrFn rowptr) {
    const int lane = et & 63, wid = et >> 6, wr = wid >> 2, wc = wid & 3, fr = lane & 15, fq = lane >> 4;
    constexpr int RS = 528;
#pragma unroll
    for (int ai = 0; ai < 2; ++ai) {
#pragma unroll
        for (int bj = 0; bj < 2; ++bj)
#pragma unroll
            for (int m = 0; m < 4; ++m)
#pragma unroll
                for (int n = 0; n < 2; ++n)
                    *reinterpret_cast<uint2*>(smem + (wr * 64 + m * 16 + fr) * RS + (bj * 128 + wc * 32 + n * 16 + fq * 4) * 2) = val(ai, bj, m, n);
        __syncthreads();
        {
            const int seg = et & 31, rq = et >> 5;
#pragma unroll
            for (int i = 0; i < 8; ++i) {
                const int rl = i * 16 + rq;
                const u32x4 v = *reinterpret_cast<const u32x4*>(smem + rl * RS + seg * 16);
                bf16_t* dst = rowptr(ai * 128 + rl);
                if (dst) *reinterpret_cast<u32x4*>(dst + seg * 8) = v;
            }
        }
        __syncthreads();
    }
}

template <class ValFn, class RowPtrFn>
__device__ __forceinline__ void store_tile_fp8(char* smem, const int et, ValFn val, RowPtrFn rowptr) {
    const int lane = et & 63, wid = et >> 6, wr = wid >> 2, wc = wid & 3, fr = lane & 15, fq = lane >> 4;
    constexpr int RS = 272;
#pragma unroll
    for (int ai = 0; ai < 2; ++ai)
#pragma unroll
        for (int bj = 0; bj < 2; ++bj)
#pragma unroll
            for (int m = 0; m < 4; ++m)
#pragma unroll
                for (int n = 0; n < 2; ++n)
                    *reinterpret_cast<int*>(smem + (ai * 128 + wr * 64 + m * 16 + fr) * RS + bj * 128 + wc * 32 + n * 16 + fq * 4) = val(ai, bj, m, n);
    __syncthreads();
    {
        const int seg = et & 15, rq = et >> 4;
#pragma unroll
        for (int i = 0; i < 8; ++i) {
            const int rl = i * 32 + rq;
            const u32x4 v = *reinterpret_cast<const u32x4*>(smem + rl * RS + seg * 16);
            unsigned char* dst = rowptr(rl);
            if (dst) *reinterpret_cast<u32x4*>(dst + seg * 16) = v;
        }
    }
    __syncthreads();
}

template <class Epi>
__device__ __forceinline__ void mini_gemm(const bf16_t* __restrict__ A, int lda, const bf16_t* __restrict__ Bt, int ldb, int K, int mb, int nbk, char* smem,
                                          const int tid, Epi epi) {
    const int lane = tid & 63, wid = tid >> 6, fr = lane & 15, fq = lane >> 4;
    const int nwk = K >= 256 ? 8 : K / 32;
    const int kslice = K / nwk;
    f32x4 acc[2][2];
#pragma unroll
    for (int m = 0; m < 2; ++m)
#pragma unroll
        for (int n = 0; n < 2; ++n) acc[m][n] = f32x4{0.f, 0.f, 0.f, 0.f};
    if (wid < nwk) {
        const int k0 = wid * kslice;
        bf16x8 a[4][2], b[4][2];
#pragma unroll
        for (int i = 0; i < 4; ++i) {
            const int ks = (i * 32 < kslice) ? i * 32 : 0;
#pragma unroll
            for (int m = 0; m < 2; ++m) a[i][m] = *reinterpret_cast<const bf16x8*>(A + (size_t)(mb * 32 + m * 16 + fr) * lda + k0 + ks + fq * 8);
#pragma unroll
            for (int n = 0; n < 2; ++n) b[i][n] = *reinterpret_cast<const bf16x8*>(Bt + (size_t)(nbk * 32 + n * 16 + fr) * ldb + k0 + ks + fq * 8);
        }
        __builtin_amdgcn_sched_barrier(0);
#pragma unroll
        for (int i = 0; i < 4; ++i) {
            if (i * 32 < kslice) {
#pragma unroll
                for (int m = 0; m < 2; ++m)
#pragma unroll
                    for (int n = 0; n < 2; ++n) acc[m][n] = __builtin_amdgcn_mfma_f32_16x16x32_bf16(b[i][n], a[i][m], acc[m][n], 0, 0, 0);
            }
        }
    }
    float* red = reinterpret_cast<float*>(smem);
    __syncthreads();
#pragma unroll
    for (int m = 0; m < 2; ++m)
#pragma unroll
        for (int n = 0; n < 2; ++n)
            *reinterpret_cast<float4*>(red + wid * 1024 + (m * 16 + fr) * 32 + n * 16 + fq * 4) = make_float4(acc[m][n][0], acc[m][n][1], acc[m][n][2], acc[m][n][3]);
    __syncthreads();
    {
        const int r = tid >> 4, c = (tid & 15) * 2;
        float v0 = 0.f, v1 = 0.f;
#pragma unroll
        for (int w = 0; w < 8; ++w) {
            float2 t = *reinterpret_cast<const float2*>(red + w * 1024 + r * 32 + c);
            v0 += t.x; v1 += t.y;
        }
        epi(mb * 32 + r, nbk * 32 + c, v0, v1);
    }
    __syncthreads();
}

__device__ __forceinline__ void pro_gemv(const Params& p, int item, char* smem, const int tid) {
    const int slice = item & 15, lc = item >> 4, l = lc >> 3, chunk = lc & 7;
    const int n0 = chunk * 768, k0 = slice * 64;
    const int cg = tid % 192, rs = tid / 192;
    float* sil = reinterpret_cast<float*>(smem);
    float* red = sil + 128;
    unsigned* flag = reinterpret_cast<unsigned*>(red + 2 * 192 * 4);
    __syncthreads();
    if (tid < 128) {
        const float a = tid < 64 ? p.in[I_C][k0 + tid] : p.in[I_CCTX][k0 + tid - 64];
        sil[tid] = a / (1.f + expf(-a));
    }
    __syncthreads();
    float ax[4] = {0.f, 0.f, 0.f, 0.f}, ac[4] = {0.f, 0.f, 0.f, 0.f};
    if (rs < 2) {
        const float* wm = p.in[I_WMOD] + ((size_t)l * 1024 + k0 + rs * 32) * 6144 + n0 + cg * 4;
#pragma unroll
        for (int r0 = 0; r0 < 32; r0 += 16) {
            float4 w[16];
#pragma unroll
            for (int r = 0; r < 16; ++r) w[r] = *reinterpret_cast<const float4*>(wm + (size_t)(r0 + r) * 6144);
            __builtin_amdgcn_sched_barrier(0);
#pragma unroll
            for (int r = 0; r < 16; ++r) {
                const float sx = sil[rs * 32 + r0 + r], sc = sil[64 + rs * 32 + r0 + r];
                ax[0] = fmaf(sx, w[r].x, ax[0]); ax[1] = fmaf(sx, w[r].y, ax[1]); ax[2] = fmaf(sx, w[r].z, ax[2]); ax[3] = fmaf(sx, w[r].w, ax[3]);
                ac[0] = fmaf(sc, w[r].x, ac[0]); ac[1] = fmaf(sc, w[r].y, ac[1]); ac[2] = fmaf(sc, w[r].z, ac[2]); ac[3] = fmaf(sc, w[r].w, ac[3]);
            }
            __builtin_amdgcn_sched_barrier(0);
        }
    }
    if (rs == 1) {
        *reinterpret_cast<float4*>(red + (0 * 192 + cg) * 4) = make_float4(ax[0], ax[1], ax[2], ax[3]);
        *reinterpret_cast<float4*>(red + (1 * 192 + cg) * 4) = make_float4(ac[0], ac[1], ac[2], ac[3]);
    }
    __syncthreads();
    float* modp = reinterpret_cast<float*>(p.ws + WS_MODP);
    if (rs == 0) {
        const float4 bx = *reinterpret_cast<const float4*>(red + (0 * 192 + cg) * 4), bc = *reinterpret_cast<const float4*>(red + (1 * 192 + cg) * 4);
        unsigned long long* d0 = reinterpret_cast<unsigned long long*>(modp + ((size_t)(l * 16 + slice) * 2 + 0) * 6144 + n0 + cg * 4);
        unsigned long long* d1 = reinterpret_cast<unsigned long long*>(modp + ((size_t)(l * 16 + slice) * 2 + 1) * 6144 + n0 + cg * 4);
        auto pk = [](float a, float b) { return (unsigned long long)__float_as_uint(a) | ((unsigned long long)__float_as_uint(b) << 32); };
        __hip_atomic_store(d0, pk(ax[0] + bx.x, ax[1] + bx.y), __ATOMIC_RELAXED, __HIP_MEMORY_SCOPE_AGENT);
        __hip_atomic_store(d0 + 1, pk(ax[2] + bx.z, ax[3] + bx.w), __ATOMIC_RELAXED, __HIP_MEMORY_SCOPE_AGENT);
        __hip_atomic_store(d1, pk(ac[0] + bc.x, ac[1] + bc.y), __ATOMIC_RELAXED, __HIP_MEMORY_SCOPE_AGENT);
        __hip_atomic_store(d1 + 1, pk(ac[2] + bc.z, ac[3] + bc.w), __ATOMIC_RELAXED, __HIP_MEMORY_SCOPE_AGENT);
    }
    asm volatile("s_waitcnt vmcnt(0)" ::: "memory");
    __syncthreads();
    if (tid == 0) {
        const unsigned old = __hip_atomic_fetch_add(reinterpret_cast<unsigned*>(p.ws + WS_GCNT) + lc, 1u, __ATOMIC_RELAXED, __HIP_MEMORY_SCOPE_AGENT);
        if (old == 15u) { __builtin_amdgcn_fence(__ATOMIC_ACQUIRE, "agent"); asm volatile("s_waitcnt vmcnt(0)" ::: "memory"); }
        *flag = old;
    }
    __syncthreads();
    if (*flag == 15u) {
        float* mod = reinterpret_cast<float*>(p.ws + WS_MOD);
        for (int idx = tid; idx < 2 * 768; idx += NTHREADS) {
            const int v = idx / 768, c = idx % 768;
            float pv[16];
#pragma unroll
            for (int sl = 0; sl < 16; ++sl) pv[sl] = __builtin_nontemporal_load(modp + ((size_t)(l * 16 + sl) * 2 + v) * 6144 + n0 + c);
            float sum = p.in[I_BMOD][l * 6144 + n0 + c];
            __builtin_amdgcn_sched_barrier(0);
#pragma unroll
            for (int sl = 0; sl < 16; ++sl) sum += pv[sl];
            mod[(l * 2 + v) * 6144 + n0 + c] = sum;
        }
    }
}

__device__ __forceinline__ void pro_ssm(const Params& p, int item, char* smem, const int tid) {
    const int lg = item / 3, sub = item % 3, l = lg >> 5, g = lg & 31;
    float* sLm = reinterpret_cast<float*>(smem);
    float* sTh = sLm + 128;
    float* sBb = sTh + 128;
    float* sC = sBb + 2 * 64 * 16 * 2;
    float* sPw = sC + 2 * 64 * 17 * 2;
    __syncthreads();
    if (tid < 128) {
        const int d = tid >> 6, pp = tid & 63;
        const int idx = ((l * 2 + d) * 32 + g) * 64 + pp;
        float are = fminf(p.in[I_ARE][idx], -1e-4f);
        float aim = p.in[I_AIM][idx];
        float dt = expf(p.in[I_LOGDT][(l * 2 + d) * 32 + g]);
        float lm = are * dt, th = aim * dt;
        sLm[tid] = lm; sTh[tid] = th;
        float lr, li;
        cpow(lm, th, 1, lr, li);
        float nr = lr - 1.f, ni = li;
        float den = are * are + aim * aim;
        float kr = (nr * are + ni * aim) / den;
        float ki = (ni * are - nr * aim) / den;
        {
            f32x4 brv[4], biv[4];
            float crv[16], civ[16];
#pragma unroll
            for (int j4 = 0; j4 < 4; ++j4) {
                brv[j4] = *reinterpret_cast<const f32x4*>(p.in[I_BRE] + (size_t)idx * 16 + j4 * 4);
                biv[j4] = *reinterpret_cast<const f32x4*>(p.in[I_BIM] + (size_t)idx * 16 + j4 * 4);
            }
#pragma unroll
            for (int i = 0; i < 16; ++i) {
                const size_t ci = ((size_t)((l * 2 + d) * 32 + g) * 16 + i) * 64 + pp;
                crv[i] = p.in[I_CRE][ci]; civ[i] = p.in[I_CIM][ci];
            }
            __builtin_amdgcn_sched_barrier(0);
#pragma unroll
            for (int j = 0; j < 16; ++j) {
                const float br = brv[j >> 2][j & 3], bi = biv[j >> 2][j & 3];
                sBb[((d * 64 + pp) * 16 + j) * 2 + 0] = kr * br - ki * bi;
                sBb[((d * 64 + pp) * 16 + j) * 2 + 1] = kr * bi + ki * br;
            }
#pragma unroll
            for (int i = 0; i < 16; ++i) {
                sC[((d * 64 + pp) * 17 + i) * 2 + 0] = crv[i];
                sC[((d * 64 + pp) * 17 + i) * 2 + 1] = civ[i];
            }
        }
    }
    __syncthreads();
    if (sub == 0) {
        bf16_t* tt = reinterpret_cast<bf16_t*>(p.ws + WS_TTAB) + (size_t)lg * 128 * 256;
        float* sK0 = sPw + 256;
        const int lane = tid & 63, w = tid >> 6, d = w >> 2, e0 = (w & 3) * 16, ij = lane & 15, kq = lane >> 4, part = kq & 1;
        float* sP0 = sK0 + 512;
        __syncthreads();
        if (tid < 128) { float re, im; cpow(sLm[tid], sTh[tid], 1, re, im); sPw[tid * 2] = re; sPw[tid * 2 + 1] = im; }
        { float re, im; cpow(sLm[d * 64 + lane], sTh[d * 64 + lane], e0, re, im); sP0[(w * 64 + lane) * 2] = re; sP0[(w * 64 + lane) * 2 + 1] = im; }
        __syncthreads();
        float pr[32], pi[32];
#pragma unroll
        for (int sx = 0; sx < 32; ++sx) {
            const int pp = 2 * sx + (kq >> 1);
            pr[sx] = sP0[(w * 64 + pp) * 2]; pi[sx] = sP0[(w * 64 + pp) * 2 + 1];
        }
        const float* cbase = sC + ((d * 64 + (kq >> 1)) * 17 + ij) * 2;
        const float* bbase = sBb + ((d * 64 + (kq >> 1)) * 16 + ij) * 2 + part;
        const float* lbase = sPw + (d * 64 + (kq >> 1)) * 2;
#pragma unroll 1
        for (int e = e0; e < e0 + 16; ++e) {
            f32x4 acc = {0.f, 0.f, 0.f, 0.f};
#pragma unroll
            for (int sx = 0; sx < 32; ++sx) {
                const float2 c2 = *reinterpret_cast<const float2*>(cbase + sx * 68);
                const float a = part == 0 ? (c2.x * pr[sx] - c2.y * pi[sx]) : -(c2.x * pi[sx] + c2.y * pr[sx]);
                acc = __builtin_amdgcn_mfma_f32_16x16x4f32(a, bbase[sx * 64], acc, 0, 0, 0);
                const float2 l2 = *reinterpret_cast<const float2*>(lbase + sx * 4);
                const float nr = pr[sx] * l2.x - pi[sx] * l2.y;
                pi[sx] = pr[sx] * l2.y + pi[sx] * l2.x; pr[sx] = nr;
            }
            if (e > 0) {
                const int di = d == 0 ? 63 + e : 63 - e;
#pragma unroll
                for (int r = 0; r < 4; ++r) tt[(size_t)di * 256 + (kq * 4 + r) * 16 + ij] = f2bf(acc[r]);
            } else {
#pragma unroll
                for (int r = 0; r < 4; ++r) sK0[(d * 16 + kq * 4 + r) * 16 + ij] = acc[r];
            }
        }
        __syncthreads();
        if (tid < 256) {
            const int i = tid >> 4, j = tid & 15;
            float v = sK0[(0 * 16 + i) * 16 + j] + sK0[(1 * 16 + i) * 16 + j];
            if (i == j) v += p.in[I_SSMD][l * 512 + g * 16 + i];
            tt[(size_t)63 * 256 + i * 16 + j] = f2bf(v);
        }
    } else if (sub == 1) {
        bf16_t* bt = reinterpret_cast<bf16_t*>(p.ws + WS_BT1) + (size_t)lg * 256 * 1024;
        for (int task = tid; task < 128 * 64; task += NTHREADS) {
            const int s = task & 63, dp = task >> 6, d = dp >> 6, pp = dp & 63;
            const int e = d == 0 ? 63 - s : s;
            float pr, pi;
            cpow(sLm[dp], sTh[dp], e, pr, pi);
            unsigned re8[8], im8[8];
#pragma unroll
            for (int j2 = 0; j2 < 8; ++j2) {
                float b0r = sBb[(dp * 16 + 2 * j2) * 2], b0i = sBb[(dp * 16 + 2 * j2) * 2 + 1];
                float b1r = sBb[(dp * 16 + 2 * j2 + 1) * 2], b1i = sBb[(dp * 16 + 2 * j2 + 1) * 2 + 1];
                re8[j2] = pack2(pr * b0r - pi * b0i, pr * b1r - pi * b1i);
                im8[j2] = pack2(pr * b0i + pi * b0r, pr * b1i + pi * b1r);
            }
            uint4* dre = reinterpret_cast<uint4*>(bt + (size_t)(d * 128 + 2 * pp) * 1024 + s * 16);
            uint4* dim_ = reinterpret_cast<uint4*>(bt + (size_t)(d * 128 + 2 * pp + 1) * 1024 + s * 16);
            dre[0] = make_uint4(re8[0], re8[1], re8[2], re8[3]);
            dre[1] = make_uint4(re8[4], re8[5], re8[6], re8[7]);
            dim_[0] = make_uint4(im8[0], im8[1], im8[2], im8[3]);
            dim_[1] = make_uint4(im8[4], im8[5], im8[6], im8[7]);
        }
    } else {
        bf16_t* vt = reinterpret_cast<bf16_t*>(p.ws + WS_VT) + (size_t)lg * 1024 * 256;
        for (int task = tid; task < 64 * 128; task += NTHREADS) {
            const int dp = task & 127, t = task >> 7, d = dp >> 6, pp = dp & 63;
            const int e = d == 0 ? t + 1 : 64 - t;
            float pr, pi;
            cpow(sLm[dp], sTh[dp], e, pr, pi);
            for (int i = 0; i < 16; ++i) {
                float cr = sC[((d * 64 + pp) * 17 + i) * 2], ci = sC[((d * 64 + pp) * 17 + i) * 2 + 1];
                float xr = cr * pr - ci * pi, xi = cr * pi + ci * pr;
                *reinterpret_cast<unsigned*>(vt + (size_t)(t * 16 + i) * 256 + d * 128 + 2 * pp) = pack2(xr, -xi);
            }
        }
        if (tid < 128) {
            float re, im;
            cpow(sLm[tid], sTh[tid], 64, re, im);
            const int d = tid >> 6, pp = tid & 63;
            float* lt = reinterpret_cast<float*>(p.ws + WS_LAMT);
            lt[(((l * 2 + d) * 32 + g) * 64 + pp) * 2 + 0] = re;
            lt[(((l * 2 + d) * 32 + g) * 64 + pp) * 2 + 1] = im;
        }
    }
    __syncthreads();
}

__device__ __forceinline__ void pro_fold(const Params& p, int item, char* smem, const int tid) {
    const int nc = item & 7, g = (item >> 3) & 3, l = item >> 5;
    float* sA = reinterpret_cast<float*>(smem);
    float* sB = sA + 128 * 132;
    const float* wpl = p.in[I_WPOOL] + (size_t)(l * 4 + g) * 128 * 128;
    const float* spl = p.in[I_SPOOL] + l * 512 + g * 128;
    const float* wo = p.in[I_WOUT] + ((size_t)l * 1024 + g * 128) * 1024 + nc * 128;
    __syncthreads();
    {
        f32x4 av[8], bv[8];
        const f32x4 sc = *reinterpret_cast<const f32x4*>(spl + (tid & 31) * 4);
#pragma unroll
        for (int i = 0; i < 8; ++i) {
            const int r = (tid >> 5) + i * 16, c4 = (tid & 31) * 4;
            av[i] = *reinterpret_cast<const f32x4*>(wpl + r * 128 + c4);
            bv[i] = *reinterpret_cast<const f32x4*>(wo + (size_t)r * 1024 + c4);
        }
        __builtin_amdgcn_sched_barrier(0);
#pragma unroll
        for (int i = 0; i < 8; ++i) {
            const int r = (tid >> 5) + i * 16, c4 = (tid & 31) * 4;
            *reinterpret_cast<f32x4*>(sA + r * 132 + c4) = av[i] * sc;
            *reinterpret_cast<f32x4*>(sB + r * 132 + c4) = bv[i];
        }
    }
    __syncthreads();
    const int lane = tid & 63, wid = tid >> 6, ij = lane & 15, kq = lane >> 4;
    f32x4 acc[8];
#pragma unroll
    for (int t = 0; t < 8; ++t) acc[t] = f32x4{0.f, 0.f, 0.f, 0.f};
#pragma unroll 4
    for (int ks = 0; ks < 32; ++ks) {
        const float a = sA[(wid * 16 + ij) * 132 + ks * 4 + kq];
#pragma unroll
        for (int t = 0; t < 8; ++t) {
            const float b = sB[(ks * 4 + kq) * 132 + t * 16 + ij];
            acc[t] = __builtin_amdgcn_mfma_f32_16x16x4f32(a, b, acc[t], 0, 0, 0);
        }
    }
    bf16_t* wt = reinterpret_cast<bf16_t*>(p.ws + WS_WOUTT) + (size_t)l * 1024 * 1024;
#pragma unroll
    for (int t = 0; t < 8; ++t) {
        const int n = nc * 128 + t * 16 + ij, c = wid * 16 + kq * 4;
        *reinterpret_cast<uint2*>(wt + (size_t)n * 1024 + g * 128 + c) = make_uint2(pack2(acc[t][0], acc[t][1]), pack2(acc[t][2], acc[t][3]));
    }
}

struct ConvDesc { const float* src; bf16_t* dst; int K, N, mode, k0, n0; };
__device__ __forceinline__ ConvDesc conv_desc(const Params& p, int tile) {
    ConvDesc d; int t; d.mode = 0;
    if (tile < 8192) {
        int m = tile >> 7; t = tile & 127; d.K = 1024; d.N = 512; d.mode = 1;
        d.src = p.in[I_WGATE] + (size_t)m * 1024 * 512; d.dst = reinterpret_cast<bf16_t*>(p.ws + WS_W1T + (size_t)m * 1024 * 1024);
    } else if (tile < 16384) {
        int u = tile - 8192; int m = u >> 7; t = u & 127; d.K = 1024; d.N = 512; d.mode = 2;
        d.src = p.in[I_WUP] + (size_t)m * 1024 * 512; d.dst = reinterpret_cast<bf16_t*>(p.ws + WS_W1T + (size_t)m * 1024 * 1024);
    } else if (tile < 24576) {
        int u = tile - 16384; int m = u >> 7; t = u & 127; d.K = 512; d.N = 1024; d.mode = 4;
        d.src = p.in[I_WDOWN] + (size_t)m * 512 * 1024; d.dst = reinterpret_cast<bf16_t*>(p.ws + WS_W2T + (size_t)m * 1024 * 512);
    } else if (tile < 25088) {
        int u = tile - 24576; int m = u >> 8; t = u & 255; d.K = 1024; d.N = 1024;
        d.src = p.in[I_WIN] + (size_t)m * 1024 * 1024; d.dst = reinterpret_cast<bf16_t*>(p.ws + WS_WINT) + (size_t)m * 1024 * 1024;
    } else if (tile < 25600) {
        int u = tile - 25088; int m = u >> 8; t = u & 255; d.K = 1024; d.N = 1024;
        d.src = p.in[I_WOUT] + (size_t)m * 1024 * 1024; d.dst = reinterpret_cast<bf16_t*>(p.ws + WS_WOUTT) + (size_t)m * 1024 * 1024;
    } else if (tile < 25728) {
        int u = tile - 25600; int m = u >> 6; t = u & 63; d.K = 512; d.N = 512;
        d.src = p.in[I_WGLU] + (size_t)m * 512 * 512; d.dst = reinterpret_cast<bf16_t*>(p.ws + WS_WGLUT) + (size_t)m * 512 * 512;
    } else {
        int u = tile - 25728; int m = u >> 2; t = u & 3; d.K = 128; d.N = 128;
        d.src = p.in[I_WPOOL] + (size_t)m * 128 * 128; d.dst = reinterpret_cast<bf16_t*>(p.ws + WS_WPOOLT) + (size_t)m * 128 * 128;
    }
    const int ntn = d.N / 64;
    d.k0 = (t / ntn) * 64; d.n0 = (t % ntn) * 64;
    if ((tile >= 25088 && tile < 25600 && d.k0 < 512) || tile >= 25728) d.mode = 3;
    return d;
}
__device__ __forceinline__ void conv_load(const ConvDesc& d, float4 (&v)[16], int lane) {
    if (d.mode == 3) return;
    const float* s0 = d.src + (size_t)(d.k0 + (lane & 3)) * d.N + d.n0 + (lane >> 2) * 4;
#pragma unroll
    for (int i = 0; i < 16; ++i) v[i] = *reinterpret_cast<const float4*>(s0 + (size_t)(4 * i) * d.N);
}
__device__ __forceinline__ void conv_store(const ConvDesc& d, const float4 (&v)[16], float* t, int lane) {
    if (d.mode == 3) return;
    {
        float* tw = t + (lane & 3) * 65 + (lane >> 2) * 4;
#pragma unroll
        for (int i = 0; i < 16; ++i) {
            float* q = tw + 4 * i * 65;
            q[0] = v[i].x; q[1] = v[i].y; q[2] = v[i].z; q[3] = v[i].w;
        }
    }
    {
        const int kc = (lane >> 3) * 8;
#pragma unroll
        for (int it = 0; it < 8; ++it) {
            const int n = it * 8 + (lane & 7);
            const float* tr = t + kc * 65 + n;
            unsigned o[4];
#pragma unroll
            for (int i = 0; i < 4; ++i) o[i] = pack2(tr[(2 * i) * 65], tr[(2 * i + 1) * 65]);
            const int ng = d.n0 + n;
            int nd = ng;
            if (d.mode == 1) nd = (ng >> 4) * 32 + (ng & 15);
            else if (d.mode == 2) nd = (ng >> 4) * 32 + 16 + (ng & 15);
            if (d.mode == 1 || d.mode == 2 || d.mode == 4) {
                int q0 = __builtin_amdgcn_cvt_pk_fp8_f32(64.f * tr[0 * 65], 64.f * tr[1 * 65], 0, false);
                q0 = __builtin_amdgcn_cvt_pk_fp8_f32(64.f * tr[2 * 65], 64.f * tr[3 * 65], q0, true);
                int q1 = __builtin_amdgcn_cvt_pk_fp8_f32(64.f * tr[4 * 65], 64.f * tr[5 * 65], 0, false);
                q1 = __builtin_amdgcn_cvt_pk_fp8_f32(64.f * tr[6 * 65], 64.f * tr[7 * 65], q1, true);
                *reinterpret_cast<uint2*>(reinterpret_cast<unsigned char*>(d.dst) + (size_t)nd * d.K + d.k0 + kc) = make_uint2((unsigned)q0, (unsigned)q1);
            } else
            *reinterpret_cast<uint4*>(d.dst + (size_t)nd * d.K + d.k0 + kc) = make_uint4(o[0], o[1], o[2], o[3]);
        }
    }
}

__device__ __forceinline__ int conv_index_tile(int kind, int i) {
    int layer = kind;
    if (kind == 0) {
        if (i >= 18432) return 24576 + (i - 18432);
        if (i >= 12288) { layer = 1; i = i - 12288 + 6144; }
    }
    const int type = i >> 12, idx = i & 4095;
    return type * 8192 + (((layer * 32 + (idx >> 7)) << 7) | (idx & 127));
}
__device__ __forceinline__ void conv_wave_loop(const Params& p, int kind, int first, int stride, int end, float* t, int lane) {
    int tA = first;
    float4 va[16], vb[16];
    ConvDesc da, db;
    if (tA < end) { da = conv_desc(p, conv_index_tile(kind, tA)); conv_load(da, va, lane); }
    while (tA < end) {
        const int tB = tA + stride;
        if (tB < end) { db = conv_desc(p, conv_index_tile(kind, tB)); conv_load(db, vb, lane); }
        conv_store(da, va, t, lane);
        tA = tB + stride;
        if (tA < end) { da = conv_desc(p, conv_index_tile(kind, tA)); conv_load(da, va, lane); }
        if (tB < end) conv_store(db, vb, t, lane);
    }
}

__device__ __forceinline__ void phase_prologue(const Params& p, int bid, int nb, char* smem, const int tid, const int parts = 7) {
    if (bid == 0) reinterpret_cast<int*>(p.ws + WS_CNT)[tid * CNT_STRIDE] = 0;
    constexpr int N_GEMV = 256, N_SSM = 2 * 32 * 3, N_CONV = 25760;
    constexpr int N_FOLD = 64;
    for (int it = bid; it < N_GEMV + N_SSM + N_FOLD; it += nb) {
        if (it < N_GEMV) { if (parts & 1) pro_gemv(p, it, smem, tid); }
        else if (it < N_GEMV + N_SSM) { if (parts & 2) pro_ssm(p, it - N_GEMV, smem, tid); }
        else pro_fold(p, it - N_GEMV - N_SSM, smem, tid);
    }
    __syncthreads();
    if (parts & 4) {
        const int lane = tid & 63, wid = tid >> 6;
        float* t = reinterpret_cast<float*>(smem) + wid * (64 * 65);
        constexpr int N_PRO = 18432 + (N_CONV - 24576);
        if (nb == 256) {
            constexpr int SPLIT = N_SSM * 8 * 9;
            if (bid < N_SSM) conv_wave_loop(p, 0, wid * N_SSM + bid, N_SSM * 8, SPLIT, t, lane);
            else conv_wave_loop(p, 0, SPLIT + wid * (256 - N_SSM) + (bid - N_SSM), (256 - N_SSM) * 8, N_PRO, t, lane);
        } else conv_wave_loop(p, 0, wid * nb + bid, nb * 8, N_PRO, t, lane);
    }
}

__device__ __forceinline__ const float* mod_ptr(const Params& p, int l, int v, int which) {
    return reinterpret_cast<const float*>(p.ws + WS_MOD) + (l * 2 + v) * 6144 + which * 1024;
}

__device__ __forceinline__ void phase_norm0(const Params& p, int bid, int nb, char* smem, const int tid) {
    const int lane = tid & 63, wid = tid >> 6;
    {
        float* wp = reinterpret_cast<float*>(p.ws + WS_WPRIME);
        float* gp = reinterpret_cast<float*>(p.ws + WS_GP);
        const float* wrt = p.in[I_WROUTER];
        for (int idx = bid * NTHREADS + tid; idx < 4 * 32768; idx += nb * NTHREADS) {
            const int lv = idx >> 15, k = (idx >> 5) & 1023;
            const float g = p.in[I_GFFN][(lv >> 1) * 1024 + k] * (1.f + mod_ptr(p, lv >> 1, lv & 1, 4)[k]);
            {
                const int e = idx & 31, ks = k >> 2, fq_ = k & 3, kg = ks >> 2, ksl = ks & 3, ln = fq_ * 16 + (e & 15), which = e >> 4;
                wp[(size_t)lv * 32768 + ((kg * 64 + ln) * 8) + ksl * 2 + which] = g * wrt[idx & 32767];
            }
            if ((idx & 31) == 0) gp[lv * 1024 + k] = g;
        }
        if (bid < 4) {
            const int lv = bid, e = tid & 31, part = tid >> 5;
            const float* sh = mod_ptr(p, lv >> 1, lv & 1, 3);
            float a = 0.f;
#pragma unroll
            for (int kb = 0; kb < 64; kb += 32) {
                float wv[32], sv[32];
#pragma unroll
                for (int k = 0; k < 32; ++k) { wv[k] = wrt[(part * 64 + kb + k) * 32 + e]; sv[k] = sh[part * 64 + kb + k]; }
                __builtin_amdgcn_sched_barrier(0);
#pragma unroll
                for (int k = 0; k < 32; ++k) a = fmaf(sv[k], wv[k], a);
            }
            float* red = reinterpret_cast<float*>(smem);
            __syncthreads();
            red[tid] = a;
            __syncthreads();
            if (tid < 32) {
                float t = 0.f;
                for (int q = 0; q < 16; ++q) t += red[q * 32 + tid];
                reinterpret_cast<float*>(p.ws + WS_RB)[lv * 32 + tid] = t;
            }
        }
    }
    bf16_t* hA = reinterpret_cast<bf16_t*>(p.ws + WS_HA);
    const float* gm = p.in[I_GMIX];
#pragma unroll 1
    for (int v = 0; v < 2; ++v) {
        const int rbeg = v == 0 ? 0 : SEQ, rend = v == 0 ? SEQ : ROWS;
        const float* sh = mod_ptr(p, 0, v, 0);
        const float* sc = mod_ptr(p, 0, v, 1);
        float4 ga[4], bb[4];
#pragma unroll
        for (int i = 0; i < 4; ++i) {
            const int k = i * 256 + lane * 4;
            const float4 g = *reinterpret_cast<const float4*>(gm + k);
            const float4 a = *reinterpret_cast<const float4*>(sc + k);
            ga[i] = make_float4(g.x * (1.f + a.x), g.y * (1.f + a.y), g.z * (1.f + a.z), g.w * (1.f + a.w));
            bb[i] = *reinterpret_cast<const float4*>(sh + k);
        }
        const float* base = v == 0 ? p.in[I_X] : p.in[I_CTX] - (size_t)SEQ * 1024;
        const int stride = nb * 8;
#pragma unroll 1
        for (int r = rbeg + bid * 8 + wid; r < rend; r += 2 * stride) {
            const int r2 = r + stride;
            const bool has2 = r2 < rend;
            const float* s0 = base + (size_t)r * 1024 + lane * 4;
            const float* s1 = base + (size_t)(has2 ? r2 : r) * 1024 + lane * 4;
            float4 x0[4], x1[4];
#pragma unroll
            for (int i = 0; i < 4; ++i) { x0[i] = *reinterpret_cast<const float4*>(s0 + i * 256); x1[i] = *reinterpret_cast<const float4*>(s1 + i * 256); }
            float q0 = 0.f, q1 = 0.f;
#pragma unroll
            for (int i = 0; i < 4; ++i) {
                q0 += x0[i].x * x0[i].x + x0[i].y * x0[i].y + x0[i].z * x0[i].z + x0[i].w * x0[i].w;
                q1 += x1[i].x * x1[i].x + x1[i].y * x1[i].y + x1[i].z * x1[i].z + x1[i].w * x1[i].w;
            }
            q0 = wave_sum(q0); q1 = wave_sum(q1);
            const float rs0 = rsqrtf(q0 * (1.f / 1024.f) + 1e-6f), rs1 = rsqrtf(q1 * (1.f / 1024.f) + 1e-6f);
#pragma unroll
            for (int i = 0; i < 4; ++i) {
                const int k = i * 256 + lane * 4;
                *reinterpret_cast<uint2*>(hA + (size_t)r * 1024 + k) =
                    make_uint2(pack2(x0[i].x * rs0 * ga[i].x + bb[i].x, x0[i].y * rs0 * ga[i].y + bb[i].y), pack2(x0[i].z * rs0 * ga[i].z + bb[i].z, x0[i].w * rs0 * ga[i].w + bb[i].w));
                if (has2)
                    *reinterpret_cast<uint2*>(hA + (size_t)r2 * 1024 + k) =
                        make_uint2(pack2(x1[i].x * rs1 * ga[i].x + bb[i].x, x1[i].y * rs1 * ga[i].y + bb[i].y), pack2(x1[i].z * rs1 * ga[i].z + bb[i].z, x1[i].w * rs1 * ga[i].w + bb[i].w));
            }
        }
    }
}

__device__ __forceinline__ void phase_win(const Params& p, int l, int bid, int nb, char* smem, const int tid) {
    const bf16_t* hA = reinterpret_cast<const bf16_t*>(p.ws + WS_HA);
    const bf16_t* wt = reinterpret_cast<const bf16_t*>(p.ws + WS_WINT) + (size_t)l * 1024 * 1024;
    bf16_t* ux = reinterpret_cast<bf16_t*>(p.ws + WS_UX);
    for (int tile = bid; tile < 256; tile += nb) {
        const int xcd = tile & 7, jj = tile >> 3;
        const int mt = xcd * 8 + (jj >> 2), nt = jj & 3;
        f32x4 acc[2][2][4][2];
        const int et = gemm256<false>(acc, p.ws, WS_HA, [&](int r) { return (mt * 256 + r) * 2048; }, WS_WINT + ((size_t)(l * 1024 + nt * 256) * 1024) * 2, 2048, 2048, smem, tid);
        const int lane = et & 63, wid = et >> 6, wr = wid >> 2, wc = wid & 3, fr = lane & 15, fq = lane >> 4;
        if (nt >= 2) {
            store_tile_bf16(smem, et,
                [&](int ai, int bj, int m, int n) { const f32x4 a = acc[ai][bj][m][n]; return make_uint2(pack2(a[0], a[1]), pack2(a[2], a[3])); },
                [&](int r) -> bf16_t* { return ux + (size_t)(mt * 256 + r) * 1024 + nt * 256; });
        } else {
            constexpr int TS = 520;
#pragma unroll
            for (int ai = 0; ai < 2; ++ai)
#pragma unroll
                for (int bj = 0; bj < 2; ++bj)
#pragma unroll
                    for (int m = 0; m < 4; ++m)
#pragma unroll
                        for (int n = 0; n < 2; ++n) {
                            const int rl = ai * 128 + wr * 64 + m * 16 + fr, cl = bj * 128 + wc * 32 + n * 16 + fq * 4;
                            const f32x4 a = acc[ai][bj][m][n];
                            *reinterpret_cast<uint2*>(smem + rl * TS + cl * 2) = make_uint2(pack2(a[0], a[1]), pack2(a[2], a[3]));
                        }
            __syncthreads();
            {
                const int cp = et & 127, seg = et >> 7;
                const int gsel = nt * 2 + (cp >> 6);
                const char* rbase = smem + (seg * 64) * TS + cp * 4;
                bf16_t* mixo = reinterpret_cast<bf16_t*>(p.ws + WS_MIX) + (size_t)(mt * 256 + seg * 64) * 1024 + nt * 256 + cp * 2;
                unsigned cv[64];
#pragma unroll
                for (int t = 0; t < 64; ++t) cv[t] = *reinterpret_cast<const unsigned*>(rbase + t * TS);
                __builtin_amdgcn_sched_barrier(0);
                auto slide = [&](auto hwc) {
                    constexpr int HW = decltype(hwc)::value;
                    float s0 = 0.f, s1 = 0.f;
#pragma unroll
                    for (int q = 0; q < HW; ++q) { s0 += bf2f((unsigned short)(cv[q] & 0xFFFF)); s1 += bf2f((unsigned short)(cv[q] >> 16)); }
#pragma unroll
                    for (int t = 0; t < 64; ++t) {
                        const int lo = t - HW > 0 ? t - HW : 0, hi = t + HW < 64 ? t + HW : 64;
                        const float inv = 1.f / (float)(hi - lo);
                        const unsigned u = cv[t];
                        *reinterpret_cast<unsigned*>(mixo + (size_t)t * 1024) = pack2(s0 * inv - bf2f((unsigned short)(u & 0xFFFF)), s1 * inv - bf2f((unsigned short)(u >> 16)));
                        if (t + HW < 64) { const unsigned a = cv[t + HW < 64 ? t + HW : 0]; s0 += bf2f((unsigned short)(a & 0xFFFF)); s1 += bf2f((unsigned short)(a >> 16)); }
                        if (t - HW >= 0) { const unsigned b = cv[t - HW >= 0 ? t - HW : 0]; s0 -= bf2f((unsigned short)(b & 0xFFFF)); s1 -= bf2f((unsigned short)(b >> 16)); }
                    }
                };
                if (gsel == 0) slide(std::integral_constant<int, 1>{});
                else if (gsel == 1) slide(std::integral_constant<int, 2>{});
                else if (gsel == 2) slide(std::integral_constant<int, 4>{});
                else slide(std::integral_constant<int, 8>{});
            }
            __syncthreads();
        }
    }
    const int coloff = l == 1 ? 512 : 0;
    const int ncb = (1024 - coloff) / 32;
    for (int it = bid; it < 8 * ncb; it += nb) {
        const int mb = it / ncb, nbk = it % ncb;
        mini_gemm(hA + (size_t)SEQ * 1024, 1024, wt + (size_t)coloff * 1024, 1024, 1024, mb, nbk, smem, tid,
                  [&](int r, int c, float v0, float v1) { *reinterpret_cast<unsigned*>(ux + (size_t)(SEQ + r) * 1024 + coloff + c) = pack2(v0, v1); });
    }
}

__device__ __forceinline__ void ssm_load_u(const Params& p, int g, int c0, int nvalid, char* sU, const int tid) {
    const bf16_t* ux = reinterpret_cast<const bf16_t*>(p.ws + WS_UX);
    for (int pc = tid; pc < 2048; pc += NTHREADS) {
        const int half = pc & 1, s = (pc >> 1) & 63, cc = pc >> 7;
        const int c = c0 + (cc < nvalid ? cc : nvalid - 1);
        uint4 v = *reinterpret_cast<const uint4*>(ux + (size_t)(c * 64 + s) * 1024 + 512 + g * 16 + half * 8);
        *reinterpret_cast<uint4*>(sU + cc * 2064 + s * 32 + half * 16) = v;
    }
}


__device__ __forceinline__ void ssm_load_u32(const Params& p, int g, int c0, char* sU, const int tid) {
    const bf16_t* ux = reinterpret_cast<const bf16_t*>(p.ws + WS_UX);
    u32x4 v[8];
#pragma unroll
    for (int i = 0; i < 8; ++i) {
        const int pc = tid + i * NTHREADS;
        const int half = pc & 1, sx = (pc >> 1) & 63, cc = pc >> 7;
        v[i] = *reinterpret_cast<const u32x4*>(ux + (size_t)((c0 + cc) * 64 + sx) * 1024 + 512 + g * 16 + half * 8);
    }
    __builtin_amdgcn_sched_barrier(0);
#pragma unroll
    for (int i = 0; i < 8; ++i) {
        const int pc = tid + i * NTHREADS;
        const int half = pc & 1, sx = (pc >> 1) & 63, cc = pc >> 7;
        *reinterpret_cast<u32x4*>(sU + cc * 2064 + sx * 32 + half * 16) = v[i];
    }
    __builtin_amdgcn_sched_barrier(0);
}
__device__ __forceinline__ void ssm_load_uctx(const Params& p, int g, char* sUc, const int tid) {
    const bf16_t* ux = reinterpret_cast<const bf16_t*>(p.ws + WS_UX);
    const int half = tid & 1, sx = (tid >> 1) & 63, cc = tid >> 7;
    uint4 v = *reinterpret_cast<const uint4*>(ux + (size_t)((NXCH + cc) * 64 + sx) * 1024 + 512 + g * 16 + half * 8);
    *reinterpret_cast<uint4*>(sUc + cc * 2064 + sx * 32 + half * 16) = v;
}

__device__ __forceinline__ void phase_s1(const Params& p, int l, int bid, int nb, char* smem, const int tid) {
    const int lane = tid & 63, wid = __builtin_amdgcn_readfirstlane(tid >> 6), fr = lane & 15, fq = lane >> 4;
    const bool last = (l == 1);
    char* sU = smem;
    char* sUc = smem + 66048;
    float* sL = reinterpret_cast<float*>(smem + 66048 + 8256);
    float* sLc = sL + 32 * 256;
    float* HLOC = reinterpret_cast<float*>(p.ws + WS_L);
    float* EAGG = reinterpret_cast<float*>(p.ws + WS_EAGG);
    float* ECTX = reinterpret_cast<float*>(p.ws + WS_ECTX);
    bf16_t* HIN = reinterpret_cast<bf16_t*>(p.ws + WS_HIN);
    for (int it = bid; it < 256; it += nb) {
        const int g = (it & 7) * 4 + (it >> 6), k = (it >> 3) & 7, c0 = k * 32;
        __syncthreads();
        ssm_load_u32(p, g, c0, sU, tid);
        ssm_load_uctx(p, g, sUc, tid);
        __syncthreads();
        const bf16_t* bt = reinterpret_cast<const bf16_t*>(p.ws + WS_BT1) + (size_t)(l * 32 + g) * 256 * 1024 + (size_t)(wid * 32 + fr) * 1024 + fq * 8;
        f32x4 acc[2][2], accc[2];
#pragma unroll
        for (int a = 0; a < 2; ++a) { accc[a] = f32x4{0, 0, 0, 0}; acc[a][0] = f32x4{0, 0, 0, 0}; acc[a][1] = f32x4{0, 0, 0, 0}; }
        const bool doctx = (wid == k);
#pragma unroll 1
        for (int kb = 0; kb < 32; kb += 8) {
            bf16x8 b0[8], b1[8];
#pragma unroll
            for (int i = 0; i < 8; ++i) {
                b0[i] = *reinterpret_cast<const bf16x8*>(bt + (kb + i) * 32);
                b1[i] = *reinterpret_cast<const bf16x8*>(bt + 16 * 1024 + (kb + i) * 32);
            }
            __builtin_amdgcn_sched_barrier(0);
#pragma unroll
            for (int i = 0; i < 8; ++i) {
                const int ks = kb + i;
                const bf16x8 a0 = *reinterpret_cast<const bf16x8*>(sU + fr * 2064 + ks * 64 + fq * 16);
                const bf16x8 a1 = *reinterpret_cast<const bf16x8*>(sU + (16 + fr) * 2064 + ks * 64 + fq * 16);
                acc[0][0] = __builtin_amdgcn_mfma_f32_16x16x32_bf16(b0[i], a0, acc[0][0], 0, 0, 0);
                acc[0][1] = __builtin_amdgcn_mfma_f32_16x16x32_bf16(b1[i], a0, acc[0][1], 0, 0, 0);
                acc[1][0] = __builtin_amdgcn_mfma_f32_16x16x32_bf16(b0[i], a1, acc[1][0], 0, 0, 0);
                acc[1][1] = __builtin_amdgcn_mfma_f32_16x16x32_bf16(b1[i], a1, acc[1][1], 0, 0, 0);
                if (doctx) {
                    const bf16x8 ac = *reinterpret_cast<const bf16x8*>(sUc + (fr & 3) * 2064 + ks * 64 + fq * 16);
                    accc[0] = __builtin_amdgcn_mfma_f32_16x16x32_bf16(b0[i], ac, accc[0], 0, 0, 0);
                    accc[1] = __builtin_amdgcn_mfma_f32_16x16x32_bf16(b1[i], ac, accc[1], 0, 0, 0);
                }
            }
            __builtin_amdgcn_sched_barrier(0);
        }
#pragma unroll
        for (int mt = 0; mt < 2; ++mt)
#pragma unroll
            for (int nn = 0; nn < 2; ++nn)
                *reinterpret_cast<float4*>(sL + (mt * 16 + fr) * 256 + wid * 32 + nn * 16 + fq * 4) = make_float4(acc[mt][nn][0], acc[mt][nn][1], acc[mt][nn][2], acc[mt][nn][3]);
        if (doctx && fr < 4) {
#pragma unroll
            for (int nn = 0; nn < 2; ++nn)
                *reinterpret_cast<float4*>(sLc + fr * 32 + nn * 16 + fq * 4) = make_float4(accc[nn][0], accc[nn][1], accc[nn][2], accc[nn][3]);
        }
        __syncthreads();
        if (tid < 128) {
            const int d = tid >> 6, pp = tid & 63, q = d * 128 + 2 * pp;
            const float* lt = reinterpret_cast<const float*>(p.ws + WS_LAMT) + (((l * 2 + d) * 32 + g) * 64 + pp) * 2;
            const float ar = lt[0], ai = lt[1];
            float hr = 0.f, hi = 0.f;
#pragma unroll 4
            for (int j = 0; j < 32; ++j) {
                const int cj = d == 0 ? j : 31 - j;
                *reinterpret_cast<float2*>(HLOC + ((size_t)(c0 + cj) * 32 + g) * 256 + q) = make_float2(hr, hi);
                const float2 lv = *reinterpret_cast<const float2*>(sL + cj * 256 + q);
                const float nr = ar * hr - ai * hi + lv.x, ni = ar * hi + ai * hr + lv.y;
                hr = nr; hi = ni;
            }
            *reinterpret_cast<float2*>(EAGG + ((size_t)g * 8 + k) * 256 + q) = make_float2(hr, hi);
        } else if (tid < 144) {
            const int sx = tid - 128, q = 32 * k + 2 * sx, d = k >> 2, pp = (q & 127) >> 1;
            const float* lt = reinterpret_cast<const float*>(p.ws + WS_LAMT) + (((l * 2 + d) * 32 + g) * 64 + pp) * 2;
            const float ar = lt[0], ai = lt[1];
            float hr = 0.f, hi = 0.f;
#pragma unroll
            for (int j = 0; j < 4; ++j) {
                const int cj = d == 0 ? j : 3 - j;
                *reinterpret_cast<unsigned*>(HIN + ((size_t)(NXCH + cj) * 32 + g) * 256 + q) = pack2(hr, hi);
                const float2 lv = *reinterpret_cast<const float2*>(sLc + cj * 32 + 2 * sx);
                const float nr = ar * hr - ai * hi + lv.x, ni = ar * hi + ai * hr + lv.y;
                hr = nr; hi = ni;
            }
            *reinterpret_cast<float2*>(ECTX + (size_t)g * 256 + q) = make_float2(hr, hi);
        }
    }
    const bf16_t* ux = reinterpret_cast<const bf16_t*>(p.ws + WS_UX);
    bf16_t* pd = reinterpret_cast<bf16_t*>(p.ws + WS_MIX);
    const int nblk = last ? 0 : CTXL / 64;
    for (int it = bid; it < nblk; it += nb) {
        const int r0 = SEQ + it * 64;
        const int seg0 = r0 < SEQ ? r0 : SEQ;
        const int segn = r0 < SEQ ? 64 : CTXL;
        const int lo_row = max(r0 - 8, seg0), hi_row = min(r0 + 72, seg0 + segn);
        __syncthreads();
#pragma unroll 4
        for (int i = tid; i < (hi_row - lo_row) * 64; i += NTHREADS)
            reinterpret_cast<uint4*>(smem)[i] = reinterpret_cast<const uint4*>(ux + (size_t)(lo_row + (i >> 6)) * 1024)[i & 63];
        __syncthreads();
        const unsigned* raw = reinterpret_cast<const unsigned*>(smem);
        const int cp = tid & 255, half = tid >> 8;
        const int h = 1 << (cp >> 6);
        const int tstart = r0 + half * 32 - seg0;
        const int base = seg0 - lo_row;
        float s0 = 0.f, s1 = 0.f;
        {
            const int lo = max(tstart - h, 0), hi = min(tstart + h, segn);
            for (int q = lo; q < hi; ++q) {
                const unsigned u = raw[(base + q) * 256 + cp];
                s0 += bf2f((unsigned short)(u & 0xFFFF)); s1 += bf2f((unsigned short)(u >> 16));
            }
        }
#pragma unroll 4
        for (int rr = 0; rr < 32; ++rr) {
            const int t = tstart + rr;
            const int lo = max(t - h, 0), hi = min(t + h, segn);
            const float inv = 1.f / (float)(hi - lo);
            const unsigned u = raw[(base + t) * 256 + cp];
            const float o0 = s0 * inv - bf2f((unsigned short)(u & 0xFFFF));
            const float o1 = s1 * inv - bf2f((unsigned short)(u >> 16));
            *reinterpret_cast<unsigned*>(pd + (size_t)(seg0 + t) * 1024 + cp * 2) = pack2(o0, o1);
            if (t + h < segn) { const unsigned a = raw[(base + t + h) * 256 + cp]; s0 += bf2f((unsigned short)(a & 0xFFFF)); s1 += bf2f((unsigned short)(a >> 16)); }
            if (t - h >= 0) { const unsigned b = raw[(base + t - h) * 256 + cp]; s0 -= bf2f((unsigned short)(b & 0xFFFF)); s1 -= bf2f((unsigned short)(b >> 16)); }
        }
    }
}

__device__ __forceinline__ void phase_s2(const Params& p, int l, int bid, int nb, char* smem, const int tid_in) {
    const bool last = (l == 1);
    char* sT = smem;
    char* sU = smem + 65536;
    char* sH = smem + 65536 + 66048;
    bf16_t* ysm = reinterpret_cast<bf16_t*>(p.ws + WS_YSM);
    const float* HLOC = reinterpret_cast<const float*>(p.ws + WS_L);
    const float* EAGG = reinterpret_cast<const float*>(p.ws + WS_EAGG);
    const float* ECTX = reinterpret_cast<const float*>(p.ws + WS_ECTX);
    const bf16_t* HIN = reinterpret_cast<const bf16_t*>(p.ws + WS_HIN);
    for (int it = bid; it < 256; it += nb) {
        int tid = tid_in;
        asm volatile("" : "+v"(tid));
        const int lane = tid & 63, wid = __builtin_amdgcn_readfirstlane(tid >> 6), fr = lane & 15, fq = lane >> 4;
        const int g = (it & 7) * 4 + (it >> 6), k = (it >> 3) & 7, c0 = k * 32;
        __syncthreads();
        {
            const uint4* src = reinterpret_cast<const uint4*>(p.ws + WS_TTAB + (size_t)(l * 32 + g) * 128 * 512);
            u32x4 tv[8];
#pragma unroll
            for (int i = 0; i < 8; ++i) { const int idx = tid + i * NTHREADS; tv[i] = reinterpret_cast<const u32x4*>(src)[idx < 4064 ? idx : 4063]; }
            __builtin_amdgcn_sched_barrier(0);
#pragma unroll
            for (int i = 0; i < 8; ++i) { const int idx = tid + i * NTHREADS; if (idx < 4064) reinterpret_cast<u32x4*>(sT)[idx] = tv[i]; }
            __builtin_amdgcn_sched_barrier(0);
        }
        ssm_load_u32(p, g, c0, sU, tid);
        if (tid < 128) {
            const int d = tid >> 6, pp = tid & 63, q = d * 128 + 2 * pp;
            const float* lt = reinterpret_cast<const float*>(p.ws + WS_LAMT) + (((l * 2 + d) * 32 + g) * 64 + pp) * 2;
            const float ar = lt[0], ai = lt[1];
            float br = ar, bi = ai;
#pragma unroll
            for (int i = 0; i < 5; ++i) { const float t = br * br - bi * bi; bi = 2.f * br * bi; br = t; }
            float2 e[8];
#pragma unroll
            for (int kk = 0; kk < 8; ++kk) e[kk] = *reinterpret_cast<const float2*>(EAGG + ((size_t)g * 8 + kk) * 256 + q);
            float2 hloc[32];
#pragma unroll
            for (int j = 0; j < 32; ++j) hloc[j] = *reinterpret_cast<const float2*>(HLOC + ((size_t)(c0 + j) * 32 + g) * 256 + q);
            const float2 ec = *reinterpret_cast<const float2*>(ECTX + (size_t)g * 256 + q);
            float hr = ec.x, hi = ec.y;
#pragma unroll
            for (int kk = 0; kk < 8; ++kk) {
                const int ki = d == 0 ? kk : 7 - kk;
                const bool use = d == 0 ? (ki < k) : (ki > k);
                if (use) { const float nr = br * hr - bi * hi + e[ki].x, ni = br * hi + bi * hr + e[ki].y; hr = nr; hi = ni; }
            }
            float pr = 1.f, pi = 0.f;
#pragma unroll
            for (int j = 0; j < 32; ++j) {
                const int cj = d == 0 ? j : 31 - j;
                const float vr = pr * hr - pi * hi + hloc[cj].x, vi = pr * hi + pi * hr + hloc[cj].y;
                *reinterpret_cast<unsigned*>(sH + cj * 528 + q * 2) = pack2(vr, vi);
                const float t = pr * ar - pi * ai; pi = pr * ai + pi * ar; pr = t;
            }
        }
        __syncthreads();
        f32x4 acc[2][8];
#pragma unroll
        for (int mt = 0; mt < 2; ++mt)
#pragma unroll
            for (int tt = 0; tt < 8; ++tt) acc[mt][tt] = f32x4{0, 0, 0, 0};
#pragma unroll 1
        for (int ks = 0; ks < 32; ++ks) {
            const bf16x8 a0 = *reinterpret_cast<const bf16x8*>(sU + fr * 2064 + ks * 64 + fq * 16);
            const bf16x8 a1 = *reinterpret_cast<const bf16x8*>(sU + (16 + fr) * 2064 + ks * 64 + fq * 16);
            const int sx = 2 * ks + (fq >> 1);
#pragma unroll
            for (int tt = 0; tt < 8; ++tt) {
                const int t = wid * 8 + tt;
                const bf16x8 b = *reinterpret_cast<const bf16x8*>(sT + (t - sx + 63) * 512 + fr * 32 + (fq & 1) * 16);
                acc[0][tt] = __builtin_amdgcn_mfma_f32_16x16x32_bf16(b, a0, acc[0][tt], 0, 0, 0);
                acc[1][tt] = __builtin_amdgcn_mfma_f32_16x16x32_bf16(b, a1, acc[1][tt], 0, 0, 0);
            }
        }
        const bf16_t* vt = reinterpret_cast<const bf16_t*>(p.ws + WS_VT) + (size_t)(l * 32 + g) * 1024 * 256 + (size_t)(wid * 128 + fr) * 256 + fq * 8;
        {
            bf16x8 bc[8], bn[8];
#pragma unroll
            for (int tt = 0; tt < 8; ++tt) bc[tt] = *reinterpret_cast<const bf16x8*>(vt + (size_t)tt * 16 * 256);
#pragma unroll
            for (int ks = 0; ks < 8; ++ks) {
                if (ks + 1 < 8) {
#pragma unroll
                    for (int tt = 0; tt < 8; ++tt) bn[tt] = *reinterpret_cast<const bf16x8*>(vt + (size_t)tt * 16 * 256 + (ks + 1) * 32);
                }
                __builtin_amdgcn_sched_barrier(0);
                const bf16x8 a0 = *reinterpret_cast<const bf16x8*>(sH + fr * 528 + ks * 64 + fq * 16);
                const bf16x8 a1 = *reinterpret_cast<const bf16x8*>(sH + (16 + fr) * 528 + ks * 64 + fq * 16);
#pragma unroll
                for (int tt = 0; tt < 8; ++tt) {
                    acc[0][tt] = __builtin_amdgcn_mfma_f32_16x16x32_bf16(bc[tt], a0, acc[0][tt], 0, 0, 0);
                    acc[1][tt] = __builtin_amdgcn_mfma_f32_16x16x32_bf16(bc[tt], a1, acc[1][tt], 0, 0, 0);
                }
                __builtin_amdgcn_sched_barrier(0);
#pragma unroll
                for (int tt = 0; tt < 8; ++tt) bc[tt] = bn[tt];
            }
        }
#pragma unroll
        for (int mt = 0; mt < 2; ++mt)
#pragma unroll
            for (int tt = 0; tt < 8; ++tt) {
                const int row = (c0 + mt * 16 + fr) * 64 + wid * 8 + tt;
                const f32x4 a = acc[mt][tt];
                *reinterpret_cast<uint2*>(ysm + (size_t)row * 512 + g * 16 + fq * 4) =
                    make_uint2(pack2(gelu_tanh(a[0]), gelu_tanh(a[1])), pack2(gelu_tanh(a[2]), gelu_tanh(a[3])));
            }
        if (!last) {
            __syncthreads();
            ssm_load_uctx(p, g, sU, tid);
            {
                const int cc = tid >> 5, i = tid & 31;
                if (tid < 128) {
                    uint4 v = *reinterpret_cast<const uint4*>(HIN + ((size_t)(NXCH + cc) * 32 + g) * 256 + i * 8);
                    *reinterpret_cast<uint4*>(sH + cc * 528 + i * 16) = v;
                }
            }
            __syncthreads();
            f32x4 ax = f32x4{0, 0, 0, 0};
            const int t = 8 * k + wid;
#pragma unroll 4
            for (int ks = 0; ks < 32; ++ks) {
                const bf16x8 a = *reinterpret_cast<const bf16x8*>(sU + (fr & 3) * 2064 + ks * 64 + fq * 16);
                const int sx = 2 * ks + (fq >> 1);
                const bf16x8 b = *reinterpret_cast<const bf16x8*>(sT + (t - sx + 63) * 512 + fr * 32 + (fq & 1) * 16);
                ax = __builtin_amdgcn_mfma_f32_16x16x32_bf16(b, a, ax, 0, 0, 0);
            }
            const bf16_t* vtc = reinterpret_cast<const bf16_t*>(p.ws + WS_VT) + (size_t)(l * 32 + g) * 1024 * 256 + (size_t)(t * 16 + fr) * 256 + fq * 8;
            {
                bf16x8 bq[8];
#pragma unroll
                for (int ks = 0; ks < 8; ++ks) bq[ks] = *reinterpret_cast<const bf16x8*>(vtc + ks * 32);
                __builtin_amdgcn_sched_barrier(0);
#pragma unroll
                for (int ks = 0; ks < 8; ++ks) {
                    const bf16x8 a = *reinterpret_cast<const bf16x8*>(sH + (fr & 3) * 528 + ks * 64 + fq * 16);
                    ax = __builtin_amdgcn_mfma_f32_16x16x32_bf16(bq[ks], a, ax, 0, 0, 0);
                }
            }
            if (fr < 4) {
                const int row = (NXCH + fr) * 64 + t;
                *reinterpret_cast<uint2*>(ysm + (size_t)row * 512 + g * 16 + fq * 4) =
                    make_uint2(pack2(gelu_tanh(ax[0]), gelu_tanh(ax[1])), pack2(gelu_tanh(ax[2]), gelu_tanh(ax[3])));
            }
        }
    }
}

__device__ __forceinline__ void phase_glu_pool(const Params& p, int l, int bid, int nb, char* smem, const int tid) {
    const bool last = (l == 1);
    const bf16_t* ysm = reinterpret_cast<const bf16_t*>(p.ws + WS_YSM);
    bf16_t* mix = reinterpret_cast<bf16_t*>(p.ws + WS_MIX);
    const float* bg = p.in[I_BGLU] + l * 512;
    const bf16_t* pd = reinterpret_cast<const bf16_t*>(p.ws + WS_PD);
    const float* sp = p.in[I_SPOOL] + l * 512;
    for (int it = bid; it < 256; it += nb) {
        if (it < 128) {
            const int mt = it >> 1, nt = it & 1;
            f32x4 acc[2][2][4][2];
            const int et = gemm256<false>(acc, p.ws, WS_YSM, [&](int r) { return (mt * 256 + r) * 1024; }, WS_WGLUT + ((size_t)(l * 512 + nt * 256) * 512) * 2, 1024, 1024, smem, tid);
            const int lane = et & 63, wid = et >> 6, wr = wid >> 2, wc = wid & 3, fr = lane & 15, fq = lane >> 4;
            float4 b4[2][2];
#pragma unroll
            for (int bj = 0; bj < 2; ++bj)
#pragma unroll
                for (int n = 0; n < 2; ++n) b4[bj][n] = *reinterpret_cast<const float4*>(bg + nt * 256 + bj * 128 + wc * 32 + n * 16 + fq * 4);
            {
                const int half = lane >> 5, sl = lane & 31;
#pragma unroll 2
                for (int j = 0; j < 16; ++j) {
                    const int rl = (wid * 16 + j) * 2 + half;
                    __builtin_amdgcn_global_load_lds((const unsigned*)(ysm + (size_t)(mt * 256 + rl) * 512 + nt * 256 + ((sl ^ (rl & 15)) << 3)),
                                                     (LAS unsigned*)((LAS unsigned char*)smem + (wid * 16 + j) * 1024), 16, 0, 0);
                }
            }
            asm volatile("s_waitcnt vmcnt(0)" ::: "memory");
            __syncthreads();
#pragma unroll
            for (int ai = 0; ai < 2; ++ai)
#pragma unroll
                for (int bj = 0; bj < 2; ++bj)
#pragma unroll
                    for (int m = 0; m < 4; ++m)
#pragma unroll
                        for (int n = 0; n < 2; ++n) {
                            const int rl = ai * 128 + wr * 64 + m * 16 + fr;
                            const int row = mt * 256 + rl, col = nt * 256 + bj * 128 + wc * 32 + n * 16 + fq * 4;
                            const int slot = (bj * 16 + wc * 4 + n * 2 + (fq >> 1)) ^ fr;
                            const uint2 y = *reinterpret_cast<const uint2*>(smem + rl * 512 + slot * 16 + (fq & 1) * 8);
                            const f32x4 a = acc[ai][bj][m][n];
                            const float4 b = b4[bj][n];
                            const float y0 = bf2f((unsigned short)(y.x & 0xFFFF)), y1 = bf2f((unsigned short)(y.x >> 16));
                            const float y2 = bf2f((unsigned short)(y.y & 0xFFFF)), y3 = bf2f((unsigned short)(y.y >> 16));
                            const float o0 = y0 * sigmoidf_fast(a[0] + b.x), o1 = y1 * sigmoidf_fast(a[1] + b.y);
                            const float o2 = y2 * sigmoidf_fast(a[2] + b.z), o3 = y3 * sigmoidf_fast(a[3] + b.w);
                            *reinterpret_cast<uint2*>(mix + (size_t)row * 1024 + 512 + col) = make_uint2(pack2(o0, o1), pack2(o2, o3));
                        }
            __syncthreads();
        } else {
            int tid2 = tid;
            asm volatile("" : "+v"(tid2));
            if (!last) {
            const bf16_t* wt = reinterpret_cast<const bf16_t*>(p.ws + WS_WGLUT) + (size_t)l * 512 * 512;
            const int i2 = it - 128;
            const int mb = i2 >> 4, nbk = i2 & 15;
            mini_gemm(ysm + (size_t)SEQ * 512, 512, wt, 512, 512, mb, nbk, smem, tid2, [&](int r, int c, float v0, float v1) {
                const unsigned yv = *reinterpret_cast<const unsigned*>(ysm + (size_t)(SEQ + r) * 512 + c);
                const float y0 = bf2f((unsigned short)(yv & 0xFFFF)), y1 = bf2f((unsigned short)(yv >> 16));
                *reinterpret_cast<unsigned*>(mix + (size_t)(SEQ + r) * 1024 + 512 + c) =
                    pack2(y0 * sigmoidf_fast(v0 + bg[c]), y1 * sigmoidf_fast(v1 + bg[c + 1]));
            });
            }
            {
                __syncthreads();
                int tid3 = tid2;
                asm volatile("" : "+v"(tid3));
                const int lane = tid3 & 63, wid = tid3 >> 6;
                float* t = reinterpret_cast<float*>(smem) + wid * (64 * 65);
                conv_wave_loop(p, 1, l * 3072 + wid * 128 + (it - 128), 128 * 8, l * 3072 + 3072, t, lane);
            }
        }
    }
}

__device__ __forceinline__ void phase_wout(const Params& p, int l, int bid, int nb, char* smem, const int tid) {
    const bf16_t* mix = reinterpret_cast<const bf16_t*>(p.ws + WS_MIX);
    const bf16_t* wt = reinterpret_cast<const bf16_t*>(p.ws + WS_WOUTT) + (size_t)l * 1024 * 1024;
    float* xcur = reinterpret_cast<float*>(p.ws + WS_XCUR);
    const float* xsrc = l == 0 ? p.in[I_X] : xcur;
    const float* g1 = mod_ptr(p, l, 0, 2);
    for (int tile = bid; tile < 256; tile += nb) {
        const int xcd = tile & 7, jj = tile >> 3;
        const int mt = xcd * 8 + (jj >> 2), nt = jj & 3;
        f32x4 acc[2][2][4][2];
        const int et = gemm256<false>(acc, p.ws, WS_MIX, [&](int r) { return (mt * 256 + r) * 2048; }, WS_WOUTT + ((size_t)(l * 1024 + nt * 256) * 1024) * 2, 2048, 2048, smem, tid);
        const int lane = et & 63, wid = et >> 6, wr = wid >> 2, wc = wid & 3, fr = lane & 15, fq = lane >> 4;
        float4 g4[2][2];
#pragma unroll
        for (int bj = 0; bj < 2; ++bj)
#pragma unroll
            for (int n = 0; n < 2; ++n) g4[bj][n] = *reinterpret_cast<const float4*>(g1 + nt * 256 + bj * 128 + wc * 32 + n * 16 + fq * 4);
#pragma unroll
        for (int ai = 0; ai < 2; ++ai) {
            {
                const float* gsrc = xsrc + (size_t)(mt * 256 + ai * 128 + wid * 16) * 1024 + nt * 256;
#pragma unroll 2
                for (int j = 0; j < 16; ++j)
                    __builtin_amdgcn_global_load_lds((const unsigned*)(gsrc + (size_t)j * 1024 + ((lane ^ j) << 2)),
                                                     (LAS unsigned*)((LAS unsigned char*)smem + (wid * 16 + j) * 1024), 16, 0, 0);
            }
            asm volatile("s_waitcnt vmcnt(0)" ::: "memory");
            __syncthreads();
#pragma unroll
            for (int bj = 0; bj < 2; ++bj)
#pragma unroll
                for (int m = 0; m < 4; ++m)
#pragma unroll
                    for (int n = 0; n < 2; ++n) {
                        const int rl = wr * 64 + m * 16 + fr;
                        const int row = mt * 256 + ai * 128 + rl, col = nt * 256 + bj * 128 + wc * 32 + n * 16 + fq * 4;
                        const int slot = (bj * 32 + wc * 8 + n * 4 + fq) ^ fr;
                        const float4 x4 = *reinterpret_cast<const float4*>(smem + rl * 1024 + slot * 16);
                        const f32x4 a = acc[ai][bj][m][n];
                        const float4 g = g4[bj][n];
                        *reinterpret_cast<float4*>(xcur + (size_t)row * 1024 + col) = make_float4(x4.x + g.x * a[0], x4.y + g.y * a[1], x4.z + g.z * a[2], x4.w + g.w * a[3]);
                    }
            __syncthreads();
        }
    }
    if (l == 0) {
        const float* g1c = mod_ptr(p, 0, 1, 2);
        const float* csrc = p.in[I_CTX];
        for (int it = bid; it < 8 * 32; it += nb) {
            const int mb = it >> 5, nbk = it & 31;
            mini_gemm(mix + (size_t)SEQ * 1024, 1024, wt, 1024, 1024, mb, nbk, smem, tid, [&](int r, int c, float v0, float v1) {
                float2 xv = *reinterpret_cast<const float2*>(csrc + (size_t)r * 1024 + c);
                float2 g2v = *reinterpret_cast<const float2*>(g1c + c);
                *reinterpret_cast<float2*>(xcur + (size_t)(SEQ + r) * 1024 + c) = make_float2(xv.x + g2v.x * v0, xv.y + g2v.y * v1);
            });
        }
    }
}

__device__ __forceinline__ void phase_router(const Params& p, int l, int bid, int nb, char* smem, const int tid) {
    const int lane = tid & 63, wid = tid >> 6, fr = lane & 15, fq = lane >> 4, pj = wid >> 1, h = wid & 1;
    const bool last = (l == 1);
    const int ntiles = (last ? SEQ : ROWS) / 16;
    const float* xcur = reinterpret_cast<const float*>(p.ws + WS_XCUR);
    bf16_t* hA = reinterpret_cast<bf16_t*>(p.ws + WS_HA);
    const float* brt = p.in[I_BROUTER];
    constexpr int XS = 130;
    constexpr int PAIR_FLOATS = 2 * 16 * XS + 512 + 16 + 2 * 512 + 16 + 64 + 16;
    float* pbase = reinterpret_cast<float*>(smem) + pj * PAIR_FLOATS;
    float* xbuf = pbase + h * (16 * XS);
    float* part = pbase + 2 * 16 * XS;
    float* sq1 = part + 512;
    float* ssc = sq1 + 16;
    float* ssl = ssc + 512;
    float* srs = ssl + 512;
    int* wcnt = reinterpret_cast<int*>(srs + 16);
    int* wbase = wcnt + 32;
    volatile int* flagA = reinterpret_cast<volatile int*>(wbase + 32);
    volatile int* flagB = flagA + 1;
    int* cntl = reinterpret_cast<int*>(p.ws + WS_CNT) + l * 8 * 32 * CNT_STRIDE;
    int* toklist = reinterpret_cast<int*>(p.ws + WS_TOKLIST);
    int* tokinfo = reinterpret_cast<int*>(p.ws + WS_TOKINFO);
    float* tokw = reinterpret_cast<float*>(p.ws + WS_TOKW);
    if (h == 0) { if (lane < 32) wcnt[lane] = 0; if (lane == 0) { *flagA = 0; *flagB = 0; } }
    __syncthreads();
    int iter = 0;
    for (int tile = pj * nb + bid; tile < ntiles; tile += nb * 4) {
        ++iter;
        const int r0 = tile * 16;
        const int lv = l * 2 + (r0 < SEQ ? 0 : 1);
        const float* wp = reinterpret_cast<const float*>(p.ws + WS_WPRIME) + (size_t)lv * 32768;
        const float* gp = reinterpret_cast<const float*>(p.ws + WS_GP) + lv * 1024;
        const float* rb = reinterpret_cast<const float*>(p.ws + WS_RB) + lv * 32;
        const float* sh = mod_ptr(p, l, lv & 1, 3);
        const int hrow = lane >> 5, kk = (lane & 31) * 4;
        const float* xsrc = xcur + (size_t)(r0 + hrow) * 1024 + kk + h * 512;
        float ssq[8];
#pragma unroll
        for (int i = 0; i < 8; ++i) ssq[i] = 0.f;
        f32x4 acc0 = {0.f, 0.f, 0.f, 0.f}, acc1 = {0.f, 0.f, 0.f, 0.f};
        float4 cur[8], nxt[8];
#pragma unroll
        for (int i = 0; i < 8; ++i) cur[i] = *reinterpret_cast<const float4*>(xsrc + (size_t)(2 * i) * 1024);
#pragma unroll 1
        for (int c = 0; c < 4; ++c) {
            if (c < 3) {
#pragma unroll
                for (int i = 0; i < 8; ++i) nxt[i] = *reinterpret_cast<const float4*>(xsrc + (size_t)(2 * i) * 1024 + (c + 1) * 128);
            }
#pragma unroll
            for (int i = 0; i < 8; ++i) {
                ssq[i] += cur[i].x * cur[i].x + cur[i].y * cur[i].y + cur[i].z * cur[i].z + cur[i].w * cur[i].w;
                float* d = xbuf + (2 * i + hrow) * XS + kk;
                *reinterpret_cast<float2*>(d) = make_float2(cur[i].x, cur[i].y);
                *reinterpret_cast<float2*>(d + 2) = make_float2(cur[i].z, cur[i].w);
            }
            const float4* wpc = reinterpret_cast<const float4*>(wp + ((size_t)((h * 4 + c) * 8) * 64 + lane) * 8);
#pragma unroll
            for (int kg = 0; kg < 8; ++kg) {
                const float4 wa = wpc[kg * 128], wb = wpc[kg * 128 + 1];
                const float* xb = xbuf + fr * XS + kg * 16 + fq;
                acc0 = __builtin_amdgcn_mfma_f32_16x16x4f32(wa.x, xb[0], acc0, 0, 0, 0);
                acc1 = __builtin_amdgcn_mfma_f32_16x16x4f32(wa.y, xb[0], acc1, 0, 0, 0);
                acc0 = __builtin_amdgcn_mfma_f32_16x16x4f32(wa.z, xb[4], acc0, 0, 0, 0);
                acc1 = __builtin_amdgcn_mfma_f32_16x16x4f32(wa.w, xb[4], acc1, 0, 0, 0);
                acc0 = __builtin_amdgcn_mfma_f32_16x16x4f32(wb.x, xb[8], acc0, 0, 0, 0);
                acc1 = __builtin_amdgcn_mfma_f32_16x16x4f32(wb.y, xb[8], acc1, 0, 0, 0);
                acc0 = __builtin_amdgcn_mfma_f32_16x16x4f32(wb.z, xb[12], acc0, 0, 0, 0);
                acc1 = __builtin_amdgcn_mfma_f32_16x16x4f32(wb.w, xb[12], acc1, 0, 0, 0);
            }
#pragma unroll
            for (int i = 0; i < 8; ++i) cur[i] = nxt[i];
        }
#pragma unroll
        for (int i = 0; i < 8; ++i) {
            float v = ssq[i];
#pragma unroll
            for (int m = 16; m >= 1; m >>= 1) v += __shfl_xor(v, m, 64);
            ssq[i] = v;
        }
        if (h == 1) {
#pragma unroll
            for (int i = 0; i < 8; ++i) if ((lane & 31) == 0) sq1[2 * i + hrow] = ssq[i];
#pragma unroll
            for (int j = 0; j < 4; ++j) { part[fr * 32 + fq * 4 + j] = acc0[j]; part[fr * 32 + 16 + fq * 4 + j] = acc1[j]; }
            asm volatile("s_waitcnt lgkmcnt(0)" ::: "memory");
            if (lane == 0) *flagA = iter;
            while (*flagB != iter) __builtin_amdgcn_s_sleep(1);
            asm volatile("" ::: "memory");
        } else {
            while (*flagA != iter) __builtin_amdgcn_s_sleep(1);
            asm volatile("" ::: "memory");
#pragma unroll
            for (int i = 0; i < 8; ++i)
                if ((lane & 31) == 0) srs[2 * i + hrow] = rsqrtf((ssq[i] + sq1[2 * i + hrow]) * (1.f / 1024.f) + 1e-6f);
            {
                const float rs = srs[fr];
#pragma unroll
                for (int j = 0; j < 4; ++j) {
                    const int e0 = fq * 4 + j, e1 = 16 + fq * 4 + j;
                    const float s0 = 1.f / (1.f + expf(-(rs * (acc0[j] + part[fr * 32 + e0]) + rb[e0])));
                    const float s1 = 1.f / (1.f + expf(-(rs * (acc1[j] + part[fr * 32 + e1]) + rb[e1])));
                    ssc[fr * 32 + e0] = s0; ssl[fr * 32 + e0] = s0 + brt[e0];
                    ssc[fr * 32 + e1] = s1; ssl[fr * 32 + e1] = s1 + brt[e1];
                }
            }
            asm volatile("s_waitcnt lgkmcnt(0)" ::: "memory");
            if (lane == 0) *flagB = iter;
            int pe0 = 0, pe1 = 0, rk0 = 0, rk1 = 0;
            if (lane < 16) {
                const int r = r0 + lane;
                const float* sl = ssl + lane * 32;
                const float* sv = ssc + lane * 32;
                int bestg = 0; float bestv = -1e30f;
#pragma unroll 1
                for (int gq = 0; gq < 4; ++gq) {
                    float m1 = -1e30f, m2 = -1e30f;
#pragma unroll
                    for (int i = 0; i < 8; ++i) {
                        const float x = sl[gq * 8 + i];
                        if (x > m1) { m2 = m1; m1 = x; } else if (x > m2) m2 = x;
                    }
                    const float gs = m1 + m2;
                    if (gs > bestv) { bestv = gs; bestg = gq; }
                }
                int e0 = 0, e1 = 0; float v0 = -1e30f, v1 = -1e30f;
#pragma unroll
                for (int i = 0; i < 8; ++i) {
                    const int e = bestg * 8 + i;
                    const float x = sl[e];
                    if (x > v0) { v1 = v0; e1 = e0; v0 = x; e0 = e; }
                    else if (x > v1) { v1 = x; e1 = e; }
                }
                const float s0 = sv[e0], s1 = sv[e1];
                const float inv = 1.f / (s0 + s1);
                *reinterpret_cast<float2*>(tokw + r * 2) = make_float2(s0 * inv, s1 * inv);
                pe0 = e0; pe1 = e1;
                rk0 = atomicAdd(&wcnt[e0], 1);
                rk1 = atomicAdd(&wcnt[e1], 1);
            }
            if (lane < 32) {
                const int c = wcnt[lane];
                wbase[lane] = c > 0 ? atomicAdd(&cntl[((tile & 7) * 32 + lane) * CNT_STRIDE], c) : 0;
                wcnt[lane] = 0;
            }
            if (lane < 16) {
                const int r = r0 + lane;
                const int p0 = wbase[pe0] + rk0, p1 = wbase[pe1] + rk1;
                toklist[pe0 * ROWS + (tile & 7) * SUBCAP + p0] = r;
                toklist[pe1 * ROWS + (tile & 7) * SUBCAP + p1] = r;
                *reinterpret_cast<int4*>(tokinfo + r * 4) = make_int4(pe0, p0, pe1, p1);
            }
        }
        float4 g4[4], b4[4];
#pragma unroll
        for (int i = 0; i < 4; ++i) {
            g4[i] = *reinterpret_cast<const float4*>(gp + i * 256 + lane * 4);
            b4[i] = *reinterpret_cast<const float4*>(sh + i * 256 + lane * 4);
        }
#pragma unroll 1
        for (int rb4 = h * 8; rb4 < h * 8 + 8; rb4 += 4) {
            float4 xr[4][4];
#pragma unroll
            for (int q = 0; q < 4; ++q)
#pragma unroll
                for (int i = 0; i < 4; ++i) xr[q][i] = *reinterpret_cast<const float4*>(xcur + (size_t)(r0 + rb4 + q) * 1024 + lane * 4 + i * 256);
            __builtin_amdgcn_sched_barrier(0);
#pragma unroll
            for (int q = 0; q < 4; ++q) {
                const float rs = srs[rb4 + q];
#pragma unroll
                for (int i = 0; i < 4; ++i) {
                    const float4 xv = xr[q][i];
                    const float o0 = xv.x * rs * g4[i].x + b4[i].x, o1 = xv.y * rs * g4[i].y + b4[i].y;
                    const float o2 = xv.z * rs * g4[i].z + b4[i].z, o3 = xv.w * rs * g4[i].w + b4[i].w;
                    {
                        int q8 = __builtin_amdgcn_cvt_pk_fp8_f32(o0, o1, 0, false);
                        q8 = __builtin_amdgcn_cvt_pk_fp8_f32(o2, o3, q8, true);
                        *reinterpret_cast<int*>(reinterpret_cast<unsigned char*>(hA) + (size_t)(r0 + rb4 + q) * 1024 + i * 256 + lane * 4) = q8;
                    }
                }
            }
            __builtin_amdgcn_sched_barrier(0);
        }
    }
}

__device__ __forceinline__ void moe_prefix(const Params& p, int l, int* sm, const int tid) {
    __syncthreads();
    if (tid < 256) {
        const int* cnt = reinterpret_cast<const int*>(p.ws + WS_CNT) + l * 8 * 32 * CNT_STRIDE;
        const int e = tid >> 3, g = tid & 7;
        const int c = cnt[(g * 32 + e) * CNT_STRIDE];
        int incl = c;
#pragma unroll
        for (int d = 1; d < 8; d <<= 1) { const int t = __shfl_up(incl, d, 8); if (g >= d) incl += t; }
        sm[64 + tid] = incl - c;
        if (g == 7) sm[320 + e] = incl;
    }
    __syncthreads();
    if (tid < 64) {
        const int c = tid < 32 ? sm[320 + tid] : 0;
        int incl = c;
#pragma unroll
        for (int d = 1; d < 32; d <<= 1) { const int t = __shfl_up(incl, d, 64); if (tid >= d) incl += t; }
        if (tid < 32) sm[tid] = incl - c;
        if (tid == 31) sm[32] = incl;
    }
    __syncthreads();
}
__device__ __forceinline__ void moe_tile(const int* sm, const int* cnt, int tm, int& e, int& mt) {
    const int nfull = sm[65], nbig = sm[98];
    int e_ = 0;
    if (tm < nfull) {
        while (sm[33 + e_ + 1] <= tm) ++e_;
        e = __builtin_amdgcn_readfirstlane(e_);
        mt = __builtin_amdgcn_readfirstlane(tm - sm[33 + e]);
    } else {
        const int off = tm < nfull + nbig ? 66 : 99;
        const int tq = tm < nfull + nbig ? tm - nfull : tm - nfull - nbig;
        while (sm[off + e_ + 1] <= tq) ++e_;
        e = __builtin_amdgcn_readfirstlane(e_);
        mt = __builtin_amdgcn_readfirstlane(cnt[e * CNT_STRIDE] >> 8);
    }
}

__device__ __forceinline__ void phase_moe(const Params& p, int l, int bid, int nb, char* smem, const int tid) {
    int* sm = reinterpret_cast<int*>(smem + LDS_SM_OFF);
    moe_prefix(p, l, sm, tid);
    volatile int* sit = reinterpret_cast<volatile int*>(smem + LDS_SM_OFF + 2048);
    const int* toklist = reinterpret_cast<const int*>(p.ws + WS_TOKLIST);
    bf16_t* hid = reinterpret_cast<bf16_t*>(p.ws + WS_UX);
    bf16_t* ybuf = reinterpret_cast<bf16_t*>(p.ws + WS_PD);
    const int vx = bid & 7;
    unsigned* qhead = reinterpret_cast<unsigned*>(p.ws + WS_MQ) + (l * 8 + vx) * 64;
    unsigned* dep = reinterpret_cast<unsigned*>(p.ws + WS_MDEP) + (size_t)l * 32 * 72;
    int c4[4], t4[4];
#pragma unroll
    for (int q = 0; q < 4; ++q) { c4[q] = __builtin_amdgcn_readfirstlane(sm[320 + vx + 8 * q]); t4[q] = (c4[q] + 255) >> 8; }
    const int n1 = (t4[0] + t4[1] + t4[2] + t4[3]) * 4;
    const int ngrp = (nb - vx + 7) >> 3;
#pragma unroll 1
    for (int itq = bid >> 3; itq < 2 * n1; itq += ngrp) {
        __syncthreads();
        const bool g2 = itq >= n1;
        const int it = g2 ? itq - n1 : itq;
        const int tm = it >> 2, nt = it & 3;
        int q = 0, tb = 0;
        if (tm >= t4[0]) { q = 1; tb = t4[0]; if (tm >= tb + t4[1]) { q = 2; tb += t4[1]; if (tm >= tb + t4[2]) { q = 3; tb += t4[2]; } } }
        const int e = vx + 8 * q, mt = tm - tb;
        const int ce = q == 0 ? c4[0] : q == 1 ? c4[1] : q == 2 ? c4[2] : c4[3];
        const int roff = __builtin_amdgcn_readfirstlane(sm[e]);
        unsigned* dp = dep + e * 72 + (mt < 72 ? mt : 71);
        if (!g2) {
            const int* tl = toklist + e * ROWS;
            int sp[8];
#pragma unroll
            for (int j = 0; j < 8; ++j) sp[j] = __builtin_amdgcn_readfirstlane(sm[64 + e * 8 + j]);
            f32x4 acc[2][2][4][2];
            const int et = gemm256<true>(acc, p.ws, WS_HA, [&](int r) { int rr = mt * 256 + r; rr = rr < ce ? rr : ce - 1;
                                                                    int g = 0;
#pragma unroll
                                                                    for (int j = 1; j < 8; ++j) g += (sp[j] <= rr) ? 1 : 0;
                                                                    int so = sp[0];
#pragma unroll
                                                                    for (int j = 1; j < 8; ++j) so = (j == g) ? sp[j] : so;
                                                                    return tl[g * SUBCAP + rr - so] * 1024; }, WS_W1T + (((size_t)(l * 32 + e) * 1024 + nt * 256) * 1024), 1024, 1024, smem, tid, ce - mt * 256);
            const int lane = et & 63, wid = et >> 6, wr = wid >> 2, wc = wid & 3, fr = lane & 15, fq = lane >> 4;
            constexpr int HS = 144;
#pragma unroll
            for (int ai = 0; ai < 2; ++ai)
#pragma unroll
                for (int m = 0; m < 4; ++m)
#pragma unroll
                    for (int bj = 0; bj < 2; ++bj) {
                        float o[4];
#pragma unroll
                        for (int j = 0; j < 4; ++j) {
                            const float gte = acc[ai][bj][m][0][j], up = acc[ai][bj][m][1][j];
                            o[j] = gte * sigmoidf_fast(gte) * up;
                        }
                        const int rl = ai * 128 + wr * 64 + m * 16 + fr, cl = bj * 64 + wc * 16 + fq * 4;
                        int q8 = __builtin_amdgcn_cvt_pk_fp8_f32(o[0], o[1], 0, false);
                        q8 = __builtin_amdgcn_cvt_pk_fp8_f32(o[2], o[3], q8, true);
                        *reinterpret_cast<int*>(smem + rl * HS + cl) = q8;
                    }
            __syncthreads();
            {
                const int seg = et & 7, rq = et >> 3;
#pragma unroll
                for (int i = 0; i < 4; ++i) {
                    const int rl = i * 64 + rq, rloc = mt * 256 + rl;
                    const u32x4 v = *reinterpret_cast<const u32x4*>(smem + rl * HS + seg * 16);
                    if (rloc < ce) {
                        const unsigned char* dst = reinterpret_cast<const unsigned char*>(hid) + (size_t)(roff + rloc) * 512 + nt * 128 + seg * 16;
                        asm volatile("global_store_dwordx4 %0, %1, off sc1\n\ts_nop 1" :: "v"(dst), "v"(v) : "memory");
                    }
                }
            }
            asm volatile("s_waitcnt vmcnt(0)" ::: "memory");
            __syncthreads();
            if (et == 0) __hip_atomic_fetch_add(dp, 1u, __ATOMIC_RELAXED, __HIP_MEMORY_SCOPE_AGENT);
        } else {
            if (tid == 0) {
                unsigned spins = 0;
                while (__hip_atomic_load(dp, __ATOMIC_RELAXED, __HIP_MEMORY_SCOPE_AGENT) < 4u) { __builtin_amdgcn_s_sleep(2); if (++spins > (1u << 22)) break; }
                __builtin_amdgcn_fence(__ATOMIC_ACQUIRE, "agent");
                asm volatile("s_waitcnt vmcnt(0)" ::: "memory");
            }
            __syncthreads();
            f32x4 acc[2][2][4][2];
            const int et = gemm256<true>(acc, p.ws, WS_UX, [&](int r) { int rr = mt * 256 + r; rr = rr < ce ? rr : ce - 1; return (roff + rr) * 512; }, WS_W2T + (((size_t)(l * 32 + e) * 1024 + nt * 256) * 512), 512, 512, smem, tid, ce - mt * 256);
            const int lane = et & 63, wid = et >> 6, wr = wid >> 2, wc = wid & 3, fr = lane & 15, fq = lane >> 4;
            store_tile_fp8(smem, et,
                [&](int ai, int bj, int m, int n) { const f32x4 a = acc[ai][bj][m][n];
                                                    int q8 = __builtin_amdgcn_cvt_pk_fp8_f32(a[0], a[1], 0, false);
                                                    return __builtin_amdgcn_cvt_pk_fp8_f32(a[2], a[3], q8, true); },
                [&](int r) -> unsigned char* { const int rloc = mt * 256 + r;
                                               return rloc < ce ? reinterpret_cast<unsigned char*>(ybuf) + (size_t)(roff + rloc) * 1024 + nt * 256 : nullptr; });
        }
    }
}


__device__ __forceinline__ void phase_combine(const Params& p, int l, int bid, int nb, char* smem, const int tid) {
    const int lane = tid & 63, wid = tid >> 6;
    const bool last = (l == 1);
    int* sm = reinterpret_cast<int*>(smem);
    moe_prefix(p, l, sm, tid);
    float* xcur = reinterpret_cast<float*>(p.ws + WS_XCUR);
    const bf16_t* ybuf = reinterpret_cast<const bf16_t*>(p.ws + WS_PD);
    bf16_t* hA = reinterpret_cast<bf16_t*>(p.ws + WS_HA);
    const int* tokinfo = reinterpret_cast<const int*>(p.ws + WS_TOKINFO);
    const float* tokw = reinterpret_cast<const float*>(p.ws + WS_TOKW);
    const int stride = nb * 8;
#pragma unroll 1
    for (int v = 0; v < (last ? 1 : 2); ++v) {
        const int rbeg = v == 0 ? 0 : SEQ, rend = v == 0 ? SEQ : ROWS;
        float4 g2r[4], ga[4], bb[4];
        {
            const float* g2 = mod_ptr(p, l, v, 5);
            const float* gm = last ? p.in[I_GFINAL] : p.in[I_GMIX] + 1024;
            const float* sh = mod_ptr(p, 1, v, 0);
            const float* sc = mod_ptr(p, 1, v, 1);
#pragma unroll
            for (int i = 0; i < 4; ++i) {
                const int k = i * 256 + lane * 4;
                g2r[i] = *reinterpret_cast<const float4*>(g2 + k);
                const float4 g = *reinterpret_cast<const float4*>(gm + k);
                if (last) { ga[i] = g; bb[i] = make_float4(0.f, 0.f, 0.f, 0.f); }
                else {
                    const float4 a = *reinterpret_cast<const float4*>(sc + k);
                    ga[i] = make_float4(g.x * (1.f + a.x), g.y * (1.f + a.y), g.z * (1.f + a.z), g.w * (1.f + a.w));
                    bb[i] = *reinterpret_cast<const float4*>(sh + k);
                }
            }
        }
        int r = rbeg + bid * 8 + wid;
        int4 ti = make_int4(0, 0, 0, 0); float2 tw = make_float2(0.f, 0.f);
        if (r < rend) { ti = *reinterpret_cast<const int4*>(tokinfo + r * 4); tw = *reinterpret_cast<const float2*>(tokw + r * 2); }
#pragma unroll 1
        while (r < rend) {
            const int rn = r + stride;
            int4 tin = ti; float2 twn = tw;
            if (rn < rend) { tin = *reinterpret_cast<const int4*>(tokinfo + rn * 4); twn = *reinterpret_cast<const float2*>(tokw + rn * 2); }
            const int tg = (r >> 4) & 7;
            const unsigned char* y0 = reinterpret_cast<const unsigned char*>(ybuf) + (size_t)(sm[ti.x] + sm[64 + ti.x * 8 + tg] + ti.y) * 1024 + lane * 4;
            const unsigned char* y1 = reinterpret_cast<const unsigned char*>(ybuf) + (size_t)(sm[ti.z] + sm[64 + ti.z * 8 + tg] + ti.w) * 1024 + lane * 4;
            const float w0 = tw.x, w1 = tw.y;
            float4 xv[4]; int ya[4], yb[4];
#pragma unroll
            for (int i = 0; i < 4; ++i) {
                xv[i] = *reinterpret_cast<const float4*>(xcur + (size_t)r * 1024 + i * 256 + lane * 4);
                ya[i] = *reinterpret_cast<const int*>(y0 + i * 256);
                yb[i] = *reinterpret_cast<const int*>(y1 + i * 256);
            }
            float ss = 0.f;
#pragma unroll
            for (int i = 0; i < 4; ++i) {
                const f32x2 a01 = __builtin_amdgcn_cvt_pk_f32_fp8(ya[i], false), a23 = __builtin_amdgcn_cvt_pk_f32_fp8(ya[i], true);
                const f32x2 b01 = __builtin_amdgcn_cvt_pk_f32_fp8(yb[i], false), b23 = __builtin_amdgcn_cvt_pk_f32_fp8(yb[i], true);
                xv[i].x += g2r[i].x * (w0 * a01[0] + w1 * b01[0]);
                xv[i].y += g2r[i].y * (w0 * a01[1] + w1 * b01[1]);
                xv[i].z += g2r[i].z * (w0 * a23[0] + w1 * b23[0]);
                xv[i].w += g2r[i].w * (w0 * a23[1] + w1 * b23[1]);
                ss += xv[i].x * xv[i].x + xv[i].y * xv[i].y + xv[i].z * xv[i].z + xv[i].w * xv[i].w;
            }
            ss = wave_sum(ss);
            const float rstd = rsqrtf(ss * (1.f / 1024.f) + 1e-6f);
#pragma unroll
            for (int i = 0; i < 4; ++i) {
                const int k = i * 256 + lane * 4;
                const float o0 = xv[i].x * rstd * ga[i].x + bb[i].x, o1 = xv[i].y * rstd * ga[i].y + bb[i].y;
                const float o2 = xv[i].z * rstd * ga[i].z + bb[i].z, o3 = xv[i].w * rstd * ga[i].w + bb[i].w;
                if (!last) {
                    *reinterpret_cast<float4*>(xcur + (size_t)r * 1024 + k) = xv[i];
                    *reinterpret_cast<uint2*>(hA + (size_t)r * 1024 + k) = make_uint2(pack2(o0, o1), pack2(o2, o3));
                } else {
                    *reinterpret_cast<float4*>(p.out + (size_t)r * 1024 + k) = make_float4(o0, o1, o2, o3);
                }
            }
            ti = tin; tw = twn; r = rn;
        }
    }
}


#define XB_TMO      128
#define XB_XCNT(j)  (256  + 64 * (j))
#define XB_XSUB(j)  (1280 + 64 * (j))
#define XB_XGEN(j)  (2304 + 64 * (j))
#define XB_TOP      3328
#define XB_TOPGEN   3392
#define XCD_BAR_WORDS 3456
#define XB_SPIN_CAP (1u << 20)
__device__ __forceinline__ unsigned xb_ld(unsigned* p)              { return __hip_atomic_load(p, __ATOMIC_RELAXED, __HIP_MEMORY_SCOPE_AGENT); }
__device__ __forceinline__ unsigned xb_add(unsigned* p, unsigned v) { return __hip_atomic_fetch_add(p, v, __ATOMIC_RELAXED, __HIP_MEMORY_SCOPE_AGENT); }
__device__ __forceinline__ unsigned xb_xcc_id() { return (unsigned)__builtin_amdgcn_s_getreg((3 << 11) | 20) & 0xFu; }
#define XB_SPIN(cond, bar) do { unsigned _sp = 0; while (cond) { __builtin_amdgcn_s_sleep(1); \
    if ((++_sp & 255u) == 0u) { if (xb_ld(&(bar)[XB_TMO])) break; if (_sp > XB_SPIN_CAP) { atomicAdd(&(bar)[XB_TMO], 1u); break; } } } } while (0)
struct XcdBarrier { unsigned* bar; unsigned x; volatile LAS unsigned* st; };
__device__ __forceinline__ XcdBarrier xcd_barrier_post(unsigned* bar, volatile LAS unsigned* st, int tid) {
    XcdBarrier b; b.bar = bar; b.x = xb_xcc_id(); b.st = st;
    if (tid == 0) (void)xb_add(&bar[XB_XCNT(b.x)], 1u);
    return b;
}
__device__ __forceinline__ void xcd_barrier_complete(unsigned* bar, unsigned x, unsigned& nloc, unsigned& nx) {
    const unsigned G = gridDim.x * gridDim.y * gridDim.z;
    unsigned sum, cnt, mine, sp = 0u;
    for (;;) {
        sum = 0u; cnt = 0u; mine = 0u;
#pragma unroll
        for (unsigned j = 0; j < 16; ++j) { const unsigned c = xb_ld(&bar[XB_XCNT(j)]); sum += c; cnt += (c > 0u) ? 1u : 0u; mine = (j == x) ? c : mine; }
        if (sum == G) break;
        __builtin_amdgcn_s_sleep(1);
        if ((++sp & 255u) == 0u) { if (xb_ld(&bar[XB_TMO])) break; if (sp > XB_SPIN_CAP) { atomicAdd(&bar[XB_TMO], 1u); break; } }
    }
    nloc = mine > 0u ? mine : 1u; nx = cnt > 0u ? cnt : 1u;
}
__device__ __forceinline__ void xcd_barrier(const XcdBarrier& b, int tid) {
    asm volatile("s_waitcnt vmcnt(0)" ::: "memory");
    __syncthreads();
    if (tid == 0) {
        unsigned* bar = b.bar;
        __builtin_amdgcn_s_waitcnt(0);
        unsigned nloc = b.st[0], nx = b.st[1];
        if (nloc == 0u) { xcd_barrier_complete(bar, b.x, nloc, nx); b.st[0] = nloc; b.st[1] = nx; }
        const unsigned old = xb_add(&bar[XB_XSUB(b.x)], 1u);
        const unsigned gen = old / nloc;
        if (old + 1u == (gen + 1u) * nloc) {
            __builtin_amdgcn_fence(__ATOMIC_RELEASE, "agent");
            asm volatile("s_waitcnt vmcnt(0)" ::: "memory");
            const unsigned og = xb_add(&bar[XB_TOP], 1u);
            const unsigned tg = og / nx;
            if (og + 1u == (tg + 1u) * nx) xb_add(&bar[XB_TOPGEN], 1u);
            else XB_SPIN(xb_ld(&bar[XB_TOPGEN]) == tg, bar);
            __builtin_amdgcn_fence(__ATOMIC_ACQUIRE, "agent");
            xb_add(&bar[XB_XGEN(b.x)], 1u);
            asm volatile("s_waitcnt vmcnt(0)" ::: "memory");
        } else {
            XB_SPIN(xb_ld(&bar[XB_XGEN(b.x)]) == gen, bar);
            __builtin_amdgcn_fence(__ATOMIC_ACQUIRE, "agent");
            asm volatile("s_waitcnt vmcnt(0)" ::: "memory");
        }
    }
    __syncthreads();
}

constexpr int N_PHASES = 18;
constexpr int PH_PER_LAYER = 8;
__device__ __forceinline__ void run_phase(const Params& p, int ph, int bid, int nb, char* smem, const int tid) {
    if (ph == 0) { phase_prologue(p, bid, nb, smem, tid); return; }
    if (ph == 1) { phase_norm0(p, bid, nb, smem, tid); return; }
    const int l = (ph - 2) / PH_PER_LAYER, q = (ph - 2) % PH_PER_LAYER;
    switch (q) {
        case 0: phase_win(p, l, bid, nb, smem, tid); break;
        case 1: phase_s1(p, l, bid, nb, smem, tid); break;
        case 2: phase_s2(p, l, bid, nb, smem, tid); break;
        case 3: phase_glu_pool(p, l, bid, nb, smem, tid); break;
        case 4: phase_wout(p, l, bid, nb, smem, tid); break;
        case 5: phase_router(p, l, bid, nb, smem, tid); break;
        case 6: phase_moe(p, l, bid, nb, smem, tid); break;
        default: phase_combine(p, l, bid, nb, smem, tid); break;
    }
}

__global__ void __launch_bounds__(NTHREADS, 2) fwd_kernel(Params p, int ph_lo, int ph_hi) {
    extern __shared__ __attribute__((aligned(16))) char smem[];
    volatile LAS unsigned* st = (volatile LAS unsigned*)(smem + LDS_BYTES - 16);
    if (threadIdx.x == 0) { st[0] = 0u; st[1] = 0u; }
    __syncthreads();
    XcdBarrier xb = xcd_barrier_post(reinterpret_cast<unsigned*>(p.ws + WS_BAR), st, threadIdx.x);
    for (int ph = ph_lo; ph < ph_hi; ++ph) {
        Params q = p;
        {
            size_t zoff = 0;
            asm volatile("" : "+s"(zoff));
            q.ws = p.ws + zoff;
            q.out = p.out + zoff;
        }
        int tid = threadIdx.x;
        asm volatile("" : "+v"(tid));
        int bid = blockIdx.x;
        asm volatile("" : "+s"(bid));
        run_phase(q, ph, bid, gridDim.x, smem, tid);
        if ((REP_MASK >> ph) & 1u) {
            xcd_barrier(xb, tid);
            if (ph == 8 || ph == 16) {
                const int lq = (ph - 2) / PH_PER_LAYER;
                if (bid == 0) {
                    if (tid < 8) reinterpret_cast<unsigned*>(q.ws + WS_MQ)[(lq * 8 + tid) * 64] = 0u;
                    for (int i = tid; i < 32 * 72; i += NTHREADS) reinterpret_cast<unsigned*>(q.ws + WS_MDEP)[lq * 32 * 72 + i] = 0u;
                }
                xcd_barrier(xb, tid);
            }
            if (ph == 7 || ph == 15) {
                if (bid == 0 && tid < 256) reinterpret_cast<int*>(q.ws + WS_CNT)[((ph - 2) / PH_PER_LAYER * 256 + tid) * CNT_STRIDE] = 0;
                xcd_barrier(xb, tid);
            }
            if (ph == 0) phase_prologue(q, bid, gridDim.x, smem, tid, PRO_PART); else run_phase(q, ph, bid, gridDim.x, smem, tid);
        }
        if (ph + 1 < ph_hi) {
            if (ph_hi < 0) cg::this_grid().sync();
            xcd_barrier(xb, tid);
        }
    }
}

extern "C" void kernel_launch(void* const* d_in, const int* in_sizes, int n_in, void* d_out, int out_size, void* d_ws, size_t ws_size,
                              hipStream_t stream) {
    if (ws_size < WS_END) { fprintf(stderr, "kernel_launch: workspace too small: %zu < %zu\n", ws_size, (size_t)WS_END); return; }
    static int inited = 0;
    static int grid = 256;
    if (!inited) {
        inited = 1;
        hipFuncSetAttribute((const void*)fwd_kernel, hipFuncAttributeMaxDynamicSharedMemorySize, LDS_BYTES);
        int dev = 0, cus = 0, per_cu = 0;
        hipGetDevice(&dev);
        hipDeviceGetAttribute(&cus, hipDeviceAttributeMultiprocessorCount, dev);
        hipOccupancyMaxActiveBlocksPerMultiprocessor(&per_cu, (const void*)fwd_kernel, NTHREADS, LDS_BYTES);
        if (per_cu < 1) per_cu = 1;
        grid = cus;
        (void)hipGetLastError();
    }
    Params p{};
    for (int i = 0; i < 28; ++i) p.in[i] = (const float*)d_in[i];
    p.out = (float*)d_out;
    p.ws = (unsigned char*)d_ws;
#if ONE_LAUNCH
    hipMemsetAsync((char*)d_ws + WS_BAR, 0, WS_CTL_BYTES, stream);
    int lo = 0, hi = N_PHASES;
    void* args[] = {&p, &lo, &hi};
    hipError_t e = hipLaunchCooperativeKernel((const void*)fwd_kernel, dim3(grid), dim3(NTHREADS), args, LDS_BYTES, stream);
    if (e != hipSuccess) fprintf(stderr, "cooperative launch failed: %s (grid %d)\n", hipGetErrorString(e), grid);
#else
    for (int ph = 0; ph < N_PHASES; ++ph) {
        hipLaunchKernelGGL(fwd_kernel, dim3(grid), dim3(NTHREADS), LDS_BYTES, stream, p, ph, ph + 1);
    }
#endif
}
```

```cpp
#include <hip/hip_runtime.h>
#include <hip/hip_bf16.h>
#include <hip/hip_cooperative_groups.h>
#include <cstdio>
#include <type_traits>
namespace cg = cooperative_groups;

#ifndef REP_MASK
#define REP_MASK 0u
#endif
#ifndef PRO_PART
#define PRO_PART 7
#endif
#ifndef ONE_LAUNCH
#define ONE_LAUNCH 1
#endif

#define LAS __attribute__((address_space(3)))
typedef unsigned short bf16_t;
using bf16x8 = __attribute__((ext_vector_type(8))) short;
using f32x4 = __attribute__((ext_vector_type(4))) float;
using u32x4 = __attribute__((ext_vector_type(4))) unsigned;
using u32x2 = __attribute__((ext_vector_type(2))) unsigned;
using i32x4 = __attribute__((ext_vector_type(4))) int;
using i32x8 = __attribute__((ext_vector_type(8))) int;
using f32x2 = __attribute__((ext_vector_type(2))) float;

constexpr int D = 1024;
constexpr int SEQ = 16384;
constexpr int CTXL = 256;
constexpr int ROWS = SEQ + CTXL;
constexpr int NE = 32;
constexpr int DE = 512;
constexpr int NCH = ROWS / 64;
constexpr int NXCH = SEQ / 64;
constexpr int NTHREADS = 512;
constexpr int LDS_BYTES = 152 * 1024;
constexpr int LDS_SM_OFF = 131072;

enum { I_X = 0, I_C, I_CTX, I_CCTX, I_WMOD, I_BMOD, I_GMIX, I_GFFN, I_WIN, I_WOUT, I_WPOOL, I_SPOOL,
       I_ARE, I_AIM, I_LOGDT, I_BRE, I_BIM, I_CRE, I_CIM, I_SSMD, I_WGLU, I_BGLU, I_WROUTER, I_BROUTER,
       I_WGATE, I_WUP, I_WDOWN, I_GFINAL };

constexpr size_t WS_W1T = 0;
constexpr size_t WS_W2T = WS_W1T + (size_t)2 * 32 * 1024 * 1024 * 2;
constexpr size_t WS_WINT = WS_W2T + (size_t)2 * 32 * 1024 * 512 * 2;
constexpr size_t WS_WOUTT = WS_WINT + (size_t)2 * 1024 * 1024 * 2;
constexpr size_t WS_WGLUT = WS_WOUTT + (size_t)2 * 1024 * 1024 * 2;
constexpr size_t WS_WPOOLT = WS_WGLUT + (size_t)2 * 512 * 512 * 2;
constexpr size_t WS_TTAB = WS_WPOOLT + (size_t)2 * 4 * 128 * 128 * 2;
constexpr size_t WS_BT1 = WS_TTAB + (size_t)2 * 32 * 128 * 256 * 2;
constexpr size_t WS_VT = WS_BT1 + (size_t)2 * 32 * 256 * 1024 * 2;
constexpr size_t WS_LAMT = WS_VT + (size_t)2 * 32 * 1024 * 256 * 2;
constexpr size_t WS_MOD = WS_LAMT + (size_t)2 * 2 * 32 * 64 * 2 * 4;
constexpr size_t WS_XCUR = WS_MOD + (size_t)2 * 2 * 6144 * 4;
constexpr size_t WS_HA = WS_XCUR + (size_t)ROWS * 1024 * 4;
constexpr size_t WS_UX = WS_HA + (size_t)ROWS * 1024 * 2;
constexpr size_t WS_PD = WS_UX + (size_t)ROWS * 1024 * 2;
constexpr size_t WS_YSM = WS_PD + (size_t)ROWS * 512 * 2;
constexpr size_t WS_MIX = WS_YSM + (size_t)ROWS * 512 * 2;
constexpr size_t WS_L = WS_MIX + (size_t)ROWS * 1024 * 2;
constexpr size_t WS_HIN = WS_L + (size_t)NCH * 32 * 256 * 4;
constexpr size_t WS_CNT = WS_HIN + (size_t)NCH * 32 * 256 * 2;
constexpr int CNT_STRIDE = 64;
constexpr int SUBCAP = ROWS / 8;
constexpr size_t WS_TOKLIST = WS_CNT + (size_t)2 * 8 * 32 * CNT_STRIDE * 4;
constexpr size_t WS_TOKINFO = WS_TOKLIST + (size_t)32 * ROWS * 4;
constexpr size_t WS_TOKW = WS_TOKINFO + (size_t)ROWS * 4 * 4;
constexpr size_t WS_WPRIME = WS_TOKW + (size_t)ROWS * 2 * 4;
constexpr size_t WS_GP = WS_WPRIME + (size_t)4 * 1024 * 32 * 4;
constexpr size_t WS_RB = WS_GP + (size_t)4 * 1024 * 4;
constexpr size_t WS_EAGG = WS_RB + 1024;
constexpr size_t WS_ECTX = WS_EAGG + (size_t)32 * 8 * 256 * 4;
constexpr size_t WS_MODP = WS_ECTX + (size_t)32 * 256 * 4;
constexpr size_t WS_BAR = WS_MODP + (size_t)2 * 16 * 2 * 6144 * 4;
constexpr size_t WS_GCNT = WS_BAR + 14336;
constexpr size_t WS_MQ = WS_BAR + 16384;
constexpr size_t WS_MDEP = WS_BAR + 20480;
constexpr size_t WS_CTL_BYTES = 65536;
constexpr size_t WS_WIN8 = WS_BAR + WS_CTL_BYTES;
constexpr size_t WS_WOUT8 = WS_WIN8 + (size_t)2 * 1024 * 1024;
constexpr size_t WS_END = WS_WOUT8 + (size_t)2 * 1024 * 1024;
constexpr size_t WS_HACTX = WS_HA + (size_t)ROWS * 1024;

struct Params {
    const float* in[28];
    float* out;
    unsigned char* ws;
};

__device__ __forceinline__ unsigned pack2(float a, float b) {
    unsigned r;
    asm("v_cvt_pk_bf16_f32 %0, %1, %2" : "=v"(r) : "v"(a), "v"(b));
    return r;
}
__device__ __forceinline__ unsigned short f2bf(float f) { return (unsigned short)(pack2(f, 0.f) & 0xFFFFu); }
__device__ __forceinline__ float bf2f(unsigned short h) { return __uint_as_float(((unsigned)h) << 16); }
__device__ __forceinline__ float sigmoidf_fast(float z) { return __builtin_amdgcn_rcpf(1.f + __builtin_amdgcn_exp2f(-1.4426950408889634f * z)); }
__device__ __forceinline__ float gelu_tanh(float x) {
    const float c2 = -2.f * 0.7978845608028654f * 1.4426950408889634f, k1 = 0.044715f;
    const float w = x * fmaf(k1 * x, x, 1.f);
    return x * __builtin_amdgcn_rcpf(1.f + __builtin_amdgcn_exp2f(c2 * w));
}
__device__ __forceinline__ float wave_sum(float v) {
#pragma unroll
    for (int m = 32; m >= 1; m >>= 1) v += __shfl_xor(v, m, 64);
    return v;
}
__device__ __forceinline__ void cpow(float lm, float th, int e, float& re, float& im) {
    float mag = expf(lm * (float)e);
    float ang = th * (float)e;
    const float inv2pi = 0.15915494309189535f;
    float k = rintf(ang * inv2pi);
    float r = fmaf(-k, 6.2831854820251465f, ang);
    r = fmaf(-k, -1.7484556000744883e-07f, r);
    float s, c;
    sincosf(r, &s, &c);
    re = mag * c; im = mag * s;
}
__device__ __forceinline__ void glds16(const void* g, void* l) {
    __builtin_amdgcn_global_load_lds((const unsigned*)g, (unsigned*)l, 16, 0, 0);
}

template <class ARow>
__device__ __forceinline__ void gemm_tile(f32x4 (&acc)[4][4], ARow arow, const bf16_t* __restrict__ Bt, int ldb, int K, char* smem, const int tid) {
    const int lane = tid & 63, wid = tid >> 6, wr = wid >> 1, wc = wid & 1, fr = lane & 15, fq = lane >> 4;
    char* sA = smem;
    char* sB = smem + 16384;
    const int rA = tid >> 2, cA = (tid & 3) * 8;
    const bf16_t* a0 = arow(rA) + cA;
    const bf16_t* a1 = arow(rA + 128) + cA;
    const bf16_t* b0 = Bt + (size_t)rA * ldb + cA;
#pragma unroll
    for (int m = 0; m < 4; ++m)
#pragma unroll
        for (int n = 0; n < 4; ++n) acc[m][n] = f32x4{0.f, 0.f, 0.f, 0.f};
#pragma unroll 1
    for (int kt = 0; kt < K; kt += 32) {
        glds16(a0 + kt, sA + tid * 16);
        glds16(a1 + kt, sA + 8192 + tid * 16);
        glds16(b0 + kt, sB + tid * 16);
        asm volatile("s_waitcnt vmcnt(0)" ::: "memory");
        __syncthreads();
        bf16x8 af[4], bfr[4];
#pragma unroll
        for (int m = 0; m < 4; ++m) af[m] = *reinterpret_cast<const bf16x8*>(sA + (wr * 64 + m * 16 + fr) * 64 + fq * 16);
#pragma unroll
        for (int n = 0; n < 4; ++n) bfr[n] = *reinterpret_cast<const bf16x8*>(sB + (wc * 64 + n * 16 + fr) * 64 + fq * 16);
#pragma unroll
        for (int m = 0; m < 4; ++m)
#pragma unroll
            for (int n = 0; n < 4; ++n) acc[m][n] = __builtin_amdgcn_mfma_f32_16x16x32_bf16(bfr[n], af[m], acc[m][n], 0, 0, 0);
        __syncthreads();
    }
}


__device__ __forceinline__ int stage_g(int rr) { return (int)((0x76452310u >> (4 * rr)) & 7u); }
__device__ __forceinline__ int lds_byte(int r, int c) {
    const int st = r >> 3, rr = r & 7, cb = c * 2;
    return st * 1024 + rr * 128 + (((cb >> 4) ^ stage_g(rr)) << 4) + (cb & 15);
}
__device__ __forceinline__ void stage_rc(int b, int& R, int& C) {
    const int st = b / 1024, sb = b % 1024, rr = sb >> 7, slot = ((sb & 127) >> 4) ^ stage_g(rr);
    R = st * 8 + rr; C = (slot * 16 + (sb & 15)) / 2;
}
#define G2_SA(b, h) (((b) * 2 + (h)) * 16384)
#define G2_SB(b, h) ((4 + (b) * 2 + (h)) * 16384)
#define G2_STAGE_A(b, h, kt) do { const char* _u = cA + (size_t)(kt) * 128; asm volatile("" : "+s"(_u)); _Pragma("unroll") for (int _i = 0; _i < 2; ++_i) \
    __builtin_amdgcn_global_load_lds((const unsigned*)(_u + voA[h][_i]), (LAS unsigned*)(lds + G2_SA(b, h) + ldsw + _i * 8192), 16, 0, 0); } while (0)
#define G2_STAGE_B(b, h, kt) do { const char* _u = cB + (size_t)(kt) * 128 + (size_t)(h) * hstepB; asm volatile("" : "+s"(_u)); _Pragma("unroll") for (int _i = 0; _i < 2; ++_i) \
    __builtin_amdgcn_global_load_lds((const unsigned*)(_u + voB[_i]), (LAS unsigned*)(lds + G2_SB(b, h) + ldsw + _i * 8192), 16, 0, 0); } while (0)
#define G2_LDA(dst, b, h) do { _Pragma("unroll") for (int m = 0; m < 4; ++m) \
    dst[m] = g2_cat(*(const LAS i32x4*)(lds + G2_SA(b, h) + aoffk[0] + m * 2048), *(const LAS i32x4*)(lds + G2_SA(b, h) + aoffk[1] + m * 2048)); } while (0)
#define G2_LDB(dst, b, h) do { _Pragma("unroll") for (int n = 0; n < 2; ++n) \
    dst[n] = g2_cat(*(const LAS i32x4*)(lds + G2_SB(b, h) + boffk[0] + n * 2048), *(const LAS i32x4*)(lds + G2_SB(b, h) + boffk[1] + n * 2048)); } while (0)
#define G2_MMA(ai, bj, At_, Bt_) do { { __builtin_amdgcn_s_setprio(1); \
    _Pragma("unroll") for (int m = 0; m < 4; ++m) _Pragma("unroll") for (int n = 0; n < 2; ++n) { \
      if constexpr (FP8) { \
        asm volatile("v_mfma_scale_f32_16x16x128_f8f6f4 %0, %1, %2, %0, %3, %4 op_sel_hi:[0,0,0]" \
                     : "+v"(acc[ai][bj][m][n]) : "v"(Bt_[n]), "v"(At_[m]), "v"(sc_w), "v"(sc_a)); \
      } else { \
        acc[ai][bj][m][n] = __builtin_amdgcn_mfma_f32_16x16x32_bf16(g2_lo(Bt_[n]), g2_lo(At_[m]), acc[ai][bj][m][n], 0, 0, 0); \
        acc[ai][bj][m][n] = __builtin_amdgcn_mfma_f32_16x16x32_bf16(g2_hi(Bt_[n]), g2_hi(At_[m]), acc[ai][bj][m][n], 0, 0, 0); \
      } } \
    __builtin_amdgcn_s_setprio(0); } } while (0)
#define G2_WAIT_V(n) asm volatile("s_waitcnt vmcnt(" #n ")" ::: "memory")
#define G2_WAIT_L(n) asm volatile("s_waitcnt lgkmcnt(" #n ")" ::: "memory")
#define G2_BAR __builtin_amdgcn_s_barrier()
#define G2_SCHED __builtin_amdgcn_sched_barrier(0)

__device__ __forceinline__ size_t uniform_off(size_t v) {
    const unsigned lo = __builtin_amdgcn_readfirstlane((unsigned)v), hi = __builtin_amdgcn_readfirstlane((unsigned)(v >> 32));
    return ((size_t)hi << 32) | lo;
}
constexpr int FP8_WSCALE = 0x79797979;
__device__ __forceinline__ i32x8 g2_cat(i32x4 a, i32x4 b) { return __builtin_shufflevector(a, b, 0, 1, 2, 3, 4, 5, 6, 7); }
__device__ __forceinline__ bf16x8 g2_lo(i32x8 v) { return __builtin_bit_cast(bf16x8, (i32x4)__builtin_shufflevector(v, v, 0, 1, 2, 3)); }
__device__ __forceinline__ bf16x8 g2_hi(i32x8 v) { return __builtin_bit_cast(bf16x8, (i32x4)__builtin_shufflevector(v, v, 4, 5, 6, 7)); }
template <bool FP8, class AOff>
__device__ __forceinline__ int gemm256(f32x4 (&acc)[2][2][4][2], const unsigned char* __restrict__ wsb, size_t aoff0, AOff aoffb, size_t boff0, int ldbB, int Kbytes,
                                        char* smem, const int tid, const int nvalid = 256) {
    LAS unsigned char* lds = (LAS unsigned char*)smem;
    const int lane = tid & 63, wid = __builtin_amdgcn_readfirstlane(tid >> 6), wr = wid >> 2, wc = wid & 3, fr = lane & 15, fq = lane >> 4;
    unsigned voA[2][2], voB[2];
#pragma unroll
    for (int i = 0; i < 2; ++i) {
        int R, C;
        stage_rc(tid * 16 + i * 8192, R, C);
        voA[0][i] = (unsigned)aoffb(R) + (unsigned)C * 2u;
        voA[1][i] = (unsigned)aoffb(128 + R) + (unsigned)C * 2u;
        voB[i] = (unsigned)(R * ldbB) + (unsigned)C * 2u;
    }
    const char* cA = reinterpret_cast<const char*>(wsb) + uniform_off(aoff0);
    const char* cB = reinterpret_cast<const char*>(wsb) + uniform_off(boff0);
    const size_t hstepB = (size_t)128 * ldbB;
    const unsigned ldsw = (unsigned)wid * 1024u;
    const int aoffk[2] = { lds_byte(wr * 64 + fr, FP8 ? fq * 16 : fq * 8), lds_byte(wr * 64 + fr, FP8 ? fq * 16 + 8 : 32 + fq * 8) };
    const int boffk[2] = { lds_byte(wc * 32 + fr, FP8 ? fq * 16 : fq * 8), lds_byte(wc * 32 + fr, FP8 ? fq * 16 + 8 : 32 + fq * 8) };
    (void)nvalid;
#pragma unroll
    for (int a = 0; a < 2; ++a)
#pragma unroll
        for (int b = 0; b < 2; ++b)
#pragma unroll
            for (int m = 0; m < 4; ++m)
#pragma unroll
                for (int n = 0; n < 2; ++n) acc[a][b][m][n] = f32x4{0.f, 0.f, 0.f, 0.f};
    i32x8 At[4], B0[2], B1[2];
    const int sc_w = FP8_WSCALE, sc_a = 0x7F7F7F7F;
    (void)sc_w; (void)sc_a;
    const int nt = Kbytes / 128;
    G2_STAGE_B(0, 0, 0); G2_STAGE_A(0, 0, 0);
    G2_STAGE_B(0, 1, 0); G2_STAGE_A(0, 1, 0);
    if (wr == 1) G2_BAR;
    G2_WAIT_V(4); G2_BAR;
    G2_STAGE_B(1, 0, 1); G2_STAGE_A(1, 0, 1); G2_STAGE_B(1, 1, 1);
    G2_WAIT_V(6); G2_BAR;
#pragma unroll 1
    for (int t = 0; t < nt - 2; t += 2) {
        G2_LDB(B0, 0, 0); G2_SCHED; G2_LDA(At, 0, 0); G2_STAGE_A(1, 1, t + 1);
        G2_WAIT_L(8); G2_BAR; G2_WAIT_L(0); G2_MMA(0, 0, At, B0); G2_BAR; G2_SCHED;
        G2_LDB(B1, 0, 1); G2_STAGE_B(0, 0, t + 2);
        G2_BAR; G2_WAIT_L(0); G2_MMA(0, 1, At, B1); G2_BAR;
        G2_LDA(At, 0, 1); G2_STAGE_A(0, 0, t + 2);
        G2_BAR; G2_WAIT_L(0); G2_MMA(1, 0, At, B0); G2_BAR; G2_SCHED;
        G2_STAGE_B(0, 1, t + 2);
        G2_WAIT_V(6); G2_BAR; G2_MMA(1, 1, At, B1); G2_BAR;
        G2_LDB(B0, 1, 0); G2_SCHED; G2_LDA(At, 1, 0); G2_STAGE_A(0, 1, t + 2);
        G2_WAIT_L(8); G2_BAR; G2_WAIT_L(0); G2_MMA(0, 0, At, B0); G2_BAR; G2_SCHED;
        G2_LDB(B1, 1, 1); G2_STAGE_B(1, 0, t + 3);
        G2_BAR; G2_WAIT_L(0); G2_MMA(0, 1, At, B1); G2_BAR;
        G2_LDA(At, 1, 1); G2_STAGE_A(1, 0, t + 3);
        G2_BAR; G2_WAIT_L(0); G2_MMA(1, 0, At, B0); G2_BAR; G2_SCHED;
        G2_STAGE_B(1, 1, t + 3);
        G2_WAIT_V(6); G2_BAR; G2_MMA(1, 1, At, B1); G2_BAR;
    }
    { G2_LDB(B0, 0, 0); G2_LDA(At, 0, 0); G2_STAGE_A(1, 1, nt - 1);
      G2_BAR; G2_WAIT_L(0); G2_MMA(0, 0, At, B0); G2_BAR;
      G2_LDB(B1, 0, 1); G2_BAR; G2_WAIT_L(0); G2_MMA(0, 1, At, B1); G2_BAR;
      G2_LDA(At, 0, 1); G2_WAIT_V(4); G2_BAR; G2_WAIT_L(0); G2_MMA(1, 0, At, B0); G2_MMA(1, 1, At, B1); G2_BAR; }
    { G2_LDB(B0, 1, 0); G2_LDA(At, 1, 0); G2_WAIT_V(2); G2_BAR; G2_WAIT_L(0); G2_MMA(0, 0, At, B0); G2_BAR;
      G2_LDB(B1, 1, 1); G2_WAIT_V(0); G2_BAR; G2_WAIT_L(0); G2_MMA(0, 1, At, B1); G2_BAR;
      G2_LDA(At, 1, 1); G2_BAR; G2_WAIT_L(0); G2_MMA(1, 0, At, B0); G2_MMA(1, 1, At, B1); G2_BAR; }
    if (wr == 0) G2_BAR;
    if constexpr (FP8) asm volatile("s_nop 15\n\ts_nop 15" ::: "memory");
    int etid = tid;
    asm volatile("" : "+v"(etid));
    return etid;
}

template <class ValFn>
__device__ __forceinline__ void store_tile_ssm(char* smem, const int et, ValFn val, bf16_t* uxg, const int row0, const int ntrel) {
    const int lane = et & 63, wid = et >> 6, wr = wid >> 2, wc = wid & 3, fr = lane & 15, fq = lane >> 4;
    constexpr int RS = 528;
#pragma unroll
    for (int ai = 0; ai < 2; ++ai) {
#pragma unroll
        for (int bj = 0; bj < 2; ++bj)
#pragma unroll
            for (int m = 0; m < 4; ++m)
#pragma unroll
                for (int n = 0; n < 2; ++n)
                    *reinterpret_cast<uint2*>(smem + (wr * 64 + m * 16 + fr) * RS + (bj * 128 + wc * 32 + n * 16 + fq * 4) * 2) = val(ai, bj, m, n);
        __syncthreads();
#pragma unroll
        for (int i = 0; i < 8; ++i) {
            const int c = wid * 8 + i, g = c >> 2, rb = c & 3;
            const int rl = rb * 32 + (lane >> 1), half = lane & 1;
            const u32x4 v = *reinterpret_cast<const u32x4*>(smem + rl * RS + g * 32 + half * 16);
            *reinterpret_cast<u32x4*>(uxg + ((size_t)(ntrel * 16 + g) * ROWS + row0 + ai * 128 + rl) * 16 + half * 8) = v;
        }
        __syncthreads();
    }
}
template <class ValFn, class RowPtrFn>
__device__ __forceinline__ void store_tile_bf16(char* smem, const int et, ValFn val, RowPtrFn rowptr) {
    const int lane = et & 63, wid = et >> 6, wr = wid >> 2, wc = wid & 3, fr = lane & 15, fq = lane >> 4;
    constexpr int RS = 528;
#pragma unroll
    for (int ai = 0; ai < 2; ++ai) {
#pragma unroll
        for (int bj = 0; bj < 2; ++bj)
#pragma unroll
            for (int m = 0; m < 4; ++m)
#pragma unroll
                for (int n = 0; n < 2; ++n)
                    *reinterpret_cast<uint2*>(smem + (wr * 64 + m * 16 + fr) * RS + (bj * 128 + wc * 32 + n * 16 + fq * 4) * 2) = val(ai, bj, m, n);
        __syncthreads();
        {
            const int seg = et & 31, rq = et >> 5;
#pragma unroll
            for (int i = 0; i < 8; ++i) {
                const int rl = i * 16 + rq;
                const u32x4 v = *reinterpret_cast<const u32x4*>(smem + rl * RS + seg * 16);
                bf16_t* dst = rowptr(ai * 128 + rl);
                if (dst) *reinterpret_cast<u32x4*>(dst + seg * 8) = v;
            }
        }
        __syncthreads();
    }
}

template <class ValFn, class RowPtrFn>
__device__ __forceinline__ void store_tile_fp8(char* smem, const int et, ValFn val, RowPtrFn rowptr) {
    const int lane = et & 63, wid = et >> 6, wr = wid >> 2, wc = wid & 3, fr = lane & 15, fq = lane >> 4;
    constexpr int RS = 272;
#pragma unroll
    for (int ai = 0; ai < 2; ++ai)
#pragma unroll
        for (int bj = 0; bj < 2; ++bj)
#pragma unroll
            for (int m = 0; m < 4; ++m)
#pragma unroll
                for (int n = 0; n < 2; ++n)
                    *reinterpret_cast<int*>(smem + (ai * 128 + wr * 64 + m * 16 + fr) * RS + bj * 128 + wc * 32 + n * 16 + fq * 4) = val(ai, bj, m, n);
    __syncthreads();
    {
        const int seg = et & 15, rq = et >> 4;
#pragma unroll
        for (int i = 0; i < 8; ++i) {
            const int rl = i * 32 + rq;
            const u32x4 v = *reinterpret_cast<const u32x4*>(smem + rl * RS + seg * 16);
            unsigned char* dst = rowptr(rl);
            if (dst) *reinterpret_cast<u32x4*>(dst + seg * 16) = v;
        }
    }
    __syncthreads();
}

template <class Epi>
__device__ __forceinline__ void mini_gemm(const bf16_t* __restrict__ A, int lda, const bf16_t* __restrict__ Bt, int ldb, int K, int mb, int nbk, char* smem,
                                          const int tid, Epi epi) {
    const int lane = tid & 63, wid = tid >> 6, fr = lane & 15, fq = lane >> 4;
    const int nwk = K >= 256 ? 8 : K / 32;
    const int kslice = K / nwk;
    f32x4 acc[2][2];
#pragma unroll
    for (int m = 0; m < 2; ++m)
#pragma unroll
        for (int n = 0; n < 2; ++n) acc[m][n] = f32x4{0.f, 0.f, 0.f, 0.f};
    if (wid < nwk) {
        const int k0 = wid * kslice;
        bf16x8 a[4][2], b[4][2];
#pragma unroll
        for (int i = 0; i < 4; ++i) {
            const int ks = (i * 32 < kslice) ? i * 32 : 0;
#pragma unroll
            for (int m = 0; m < 2; ++m) a[i][m] = *reinterpret_cast<const bf16x8*>(A + (size_t)(mb * 32 + m * 16 + fr) * lda + k0 + ks + fq * 8);
#pragma unroll
            for (int n = 0; n < 2; ++n) b[i][n] = *reinterpret_cast<const bf16x8*>(Bt + (size_t)(nbk * 32 + n * 16 + fr) * ldb + k0 + ks + fq * 8);
        }
        __builtin_amdgcn_sched_barrier(0);
#pragma unroll
        for (int i = 0; i < 4; ++i) {
            if (i * 32 < kslice) {
#pragma unroll
                for (int m = 0; m < 2; ++m)
#pragma unroll
                    for (int n = 0; n < 2; ++n) acc[m][n] = __builtin_amdgcn_mfma_f32_16x16x32_bf16(b[i][n], a[i][m], acc[m][n], 0, 0, 0);
            }
        }
    }
    float* red = reinterpret_cast<float*>(smem);
    __syncthreads();
#pragma unroll
    for (int m = 0; m < 2; ++m)
#pragma unroll
        for (int n = 0; n < 2; ++n)
            *reinterpret_cast<float4*>(red + wid * 1024 + (m * 16 + fr) * 32 + n * 16 + fq * 4) = make_float4(acc[m][n][0], acc[m][n][1], acc[m][n][2], acc[m][n][3]);
    __syncthreads();
    {
        const int r = tid >> 4, c = (tid & 15) * 2;
        float v0 = 0.f, v1 = 0.f;
#pragma unroll
        for (int w = 0; w < 8; ++w) {
            float2 t = *reinterpret_cast<const float2*>(red + w * 1024 + r * 32 + c);
            v0 += t.x; v1 += t.y;
        }
        epi(mb * 32 + r, nbk * 32 + c, v0, v1);
    }
    __syncthreads();
}

__device__ __forceinline__ void pro_gemv(const Params& p, int item, char* smem, const int tid) {
    const int slice = item & 15, lc = item >> 4, l = lc >> 3, chunk = lc & 7;
    const int n0 = chunk * 768, k0 = slice * 64;
    const int cg = tid % 192, rs = tid / 192;
    float* sil = reinterpret_cast<float*>(smem);
    float* red = sil + 128;
    unsigned* flag = reinterpret_cast<unsigned*>(red + 2 * 192 * 4);
    __syncthreads();
    if (tid < 128) {
        const float a = tid < 64 ? p.in[I_C][k0 + tid] : p.in[I_CCTX][k0 + tid - 64];
        sil[tid] = a / (1.f + expf(-a));
    }
    __syncthreads();
    float ax[4] = {0.f, 0.f, 0.f, 0.f}, ac[4] = {0.f, 0.f, 0.f, 0.f};
    if (rs < 2) {
        const float* wm = p.in[I_WMOD] + ((size_t)l * 1024 + k0 + rs * 32) * 6144 + n0 + cg * 4;
#pragma unroll
        for (int r0 = 0; r0 < 32; r0 += 16) {
            float4 w[16];
#pragma unroll
            for (int r = 0; r < 16; ++r) { const f32x4 q = __builtin_nontemporal_load(reinterpret_cast<const f32x4*>(wm + (size_t)(r0 + r) * 6144)); w[r] = make_float4(q[0], q[1], q[2], q[3]); }
            __builtin_amdgcn_sched_barrier(0);
#pragma unroll
            for (int r = 0; r < 16; ++r) {
                const float sx = sil[rs * 32 + r0 + r], sc = sil[64 + rs * 32 + r0 + r];
                ax[0] = fmaf(sx, w[r].x, ax[0]); ax[1] = fmaf(sx, w[r].y, ax[1]); ax[2] = fmaf(sx, w[r].z, ax[2]); ax[3] = fmaf(sx, w[r].w, ax[3]);
                ac[0] = fmaf(sc, w[r].x, ac[0]); ac[1] = fmaf(sc, w[r].y, ac[1]); ac[2] = fmaf(sc, w[r].z, ac[2]); ac[3] = fmaf(sc, w[r].w, ac[3]);
            }
            __builtin_amdgcn_sched_barrier(0);
        }
    }
    if (rs == 1) {
        *reinterpret_cast<float4*>(red + (0 * 192 + cg) * 4) = make_float4(ax[0], ax[1], ax[2], ax[3]);
        *reinterpret_cast<float4*>(red + (1 * 192 + cg) * 4) = make_float4(ac[0], ac[1], ac[2], ac[3]);
    }
    __syncthreads();
    float* modp = reinterpret_cast<float*>(p.ws + WS_MODP);
    if (rs == 0) {
        const float4 bx = *reinterpret_cast<const float4*>(red + (0 * 192 + cg) * 4), bc = *reinterpret_cast<const float4*>(red + (1 * 192 + cg) * 4);
        unsigned long long* d0 = reinterpret_cast<unsigned long long*>(modp + ((size_t)(l * 16 + slice) * 2 + 0) * 6144 + n0 + cg * 4);
        unsigned long long* d1 = reinterpret_cast<unsigned long long*>(modp + ((size_t)(l * 16 + slice) * 2 + 1) * 6144 + n0 + cg * 4);
        auto pk = [](float a, float b) { return (unsigned long long)__float_as_uint(a) | ((unsigned long long)__float_as_uint(b) << 32); };
        __hip_atomic_store(d0, pk(ax[0] + bx.x, ax[1] + bx.y), __ATOMIC_RELAXED, __HIP_MEMORY_SCOPE_AGENT);
        __hip_atomic_store(d0 + 1, pk(ax[2] + bx.z, ax[3] + bx.w), __ATOMIC_RELAXED, __HIP_MEMORY_SCOPE_AGENT);
        __hip_atomic_store(d1, pk(ac[0] + bc.x, ac[1] + bc.y), __ATOMIC_RELAXED, __HIP_MEMORY_SCOPE_AGENT);
        __hip_atomic_store(d1 + 1, pk(ac[2] + bc.z, ac[3] + bc.w), __ATOMIC_RELAXED, __HIP_MEMORY_SCOPE_AGENT);
    }
    asm volatile("s_waitcnt vmcnt(0)" ::: "memory");
    __syncthreads();
    if (tid == 0) {
        const unsigned old = __hip_atomic_fetch_add(reinterpret_cast<unsigned*>(p.ws + WS_GCNT) + lc, 1u, __ATOMIC_RELAXED, __HIP_MEMORY_SCOPE_AGENT);
        if (old == 15u) { __builtin_amdgcn_fence(__ATOMIC_ACQUIRE, "agent"); asm volatile("s_waitcnt vmcnt(0)" ::: "memory"); }
        *flag = old;
    }
    __syncthreads();
    if (*flag == 15u) {
        float* mod = reinterpret_cast<float*>(p.ws + WS_MOD);
        for (int idx = tid; idx < 2 * 768; idx += NTHREADS) {
            const int v = idx / 768, c = idx % 768;
            float pv[16];
#pragma unroll
            for (int sl = 0; sl < 16; ++sl) pv[sl] = __builtin_nontemporal_load(modp + ((size_t)(l * 16 + sl) * 2 + v) * 6144 + n0 + c);
            float sum = p.in[I_BMOD][l * 6144 + n0 + c];
            __builtin_amdgcn_sched_barrier(0);
#pragma unroll
            for (int sl = 0; sl < 16; ++sl) sum += pv[sl];
            mod[(l * 2 + v) * 6144 + n0 + c] = sum;
        }
    }
}

__device__ __forceinline__ void pro_ssm(const Params& p, int item, char* smem, const int tid) {
    const int lg = item / 3, sub = item % 3, l = lg >> 5, g = lg & 31;
    float* sLm = reinterpret_cast<float*>(smem);
    float* sTh = sLm + 128;
    float* sBb = sTh + 128;
    float* sC = sBb + 2 * 64 * 16 * 2;
    float* sPw = sC + 2 * 64 * 17 * 2;
    __syncthreads();
    if (tid < 128) {
        const int d = tid >> 6, pp = tid & 63;
        const int idx = ((l * 2 + d) * 32 + g) * 64 + pp;
        float are = fminf(p.in[I_ARE][idx], -1e-4f);
        float aim = p.in[I_AIM][idx];
        float dt = expf(p.in[I_LOGDT][(l * 2 + d) * 32 + g]);
        float lm = are * dt, th = aim * dt;
        sLm[tid] = lm; sTh[tid] = th;
        float lr, li;
        cpow(lm, th, 1, lr, li);
        float nr = lr - 1.f, ni = li;
        float den = are * are + aim * aim;
        float kr = (nr * are + ni * aim) / den;
        float ki = (ni * are - nr * aim) / den;
        {
            f32x4 brv[4], biv[4];
            float crv[16], civ[16];
#pragma unroll
            for (int j4 = 0; j4 < 4; ++j4) {
                brv[j4] = *reinterpret_cast<const f32x4*>(p.in[I_BRE] + (size_t)idx * 16 + j4 * 4);
                biv[j4] = *reinterpret_cast<const f32x4*>(p.in[I_BIM] + (size_t)idx * 16 + j4 * 4);
            }
#pragma unroll
            for (int i = 0; i < 16; ++i) {
                const size_t ci = ((size_t)((l * 2 + d) * 32 + g) * 16 + i) * 64 + pp;
                crv[i] = p.in[I_CRE][ci]; civ[i] = p.in[I_CIM][ci];
            }
            __builtin_amdgcn_sched_barrier(0);
#pragma unroll
            for (int j = 0; j < 16; ++j) {
                const float br = brv[j >> 2][j & 3], bi = biv[j >> 2][j & 3];
                sBb[((d * 64 + pp) * 16 + j) * 2 + 0] = kr * br - ki * bi;
                sBb[((d * 64 + pp) * 16 + j) * 2 + 1] = kr * bi + ki * br;
            }
#pragma unroll
            for (int i = 0; i < 16; ++i) {
                sC[((d * 64 + pp) * 17 + i) * 2 + 0] = crv[i];
                sC[((d * 64 + pp) * 17 + i) * 2 + 1] = civ[i];
            }
        }
    }
    __syncthreads();
    if (sub == 0) {
        bf16_t* tt = reinterpret_cast<bf16_t*>(p.ws + WS_TTAB) + (size_t)lg * 128 * 256;
        float* sK0 = sPw + 256;
        const int lane = tid & 63, w = tid >> 6, d = w >> 2, e0 = (w & 3) * 16, ij = lane & 15, kq = lane >> 4, part = kq & 1;
        float* sP0 = sK0 + 512;
        __syncthreads();
        if (tid < 128) { float re, im; cpow(sLm[tid], sTh[tid], 1, re, im); sPw[tid * 2] = re; sPw[tid * 2 + 1] = im; }
        { float re, im; cpow(sLm[d * 64 + lane], sTh[d * 64 + lane], e0, re, im); sP0[(w * 64 + lane) * 2] = re; sP0[(w * 64 + lane) * 2 + 1] = im; }
        __syncthreads();
        float pr[32], pi[32];
#pragma unroll
        for (int sx = 0; sx < 32; ++sx) {
            const int pp = 2 * sx + (kq >> 1);
            pr[sx] = sP0[(w * 64 + pp) * 2]; pi[sx] = sP0[(w * 64 + pp) * 2 + 1];
        }
        const float* cbase = sC + ((d * 64 + (kq >> 1)) * 17 + ij) * 2;
        const float* bbase = sBb + ((d * 64 + (kq >> 1)) * 16 + ij) * 2 + part;
        const float* lbase = sPw + (d * 64 + (kq >> 1)) * 2;
#pragma unroll 1
        for (int e = e0; e < e0 + 16; ++e) {
            f32x4 acc = {0.f, 0.f, 0.f, 0.f};
#pragma unroll
            for (int sx = 0; sx < 32; ++sx) {
                const float2 c2 = *reinterpret_cast<const float2*>(cbase + sx * 68);
                const float a = part == 0 ? (c2.x * pr[sx] - c2.y * pi[sx]) : -(c2.x * pi[sx] + c2.y * pr[sx]);
                acc = __builtin_amdgcn_mfma_f32_16x16x4f32(a, bbase[sx * 64], acc, 0, 0, 0);
                const float2 l2 = *reinterpret_cast<const float2*>(lbase + sx * 4);
                const float nr = pr[sx] * l2.x - pi[sx] * l2.y;
                pi[sx] = pr[sx] * l2.y + pi[sx] * l2.x; pr[sx] = nr;
            }
            if (e > 0) {
                const int di = d == 0 ? 63 + e : 63 - e;
#pragma unroll
                for (int r = 0; r < 4; ++r) tt[(size_t)di * 256 + (kq * 4 + r) * 16 + ij] = f2bf(acc[r]);
            } else {
#pragma unroll
                for (int r = 0; r < 4; ++r) sK0[(d * 16 + kq * 4 + r) * 16 + ij] = acc[r];
            }
        }
        __syncthreads();
        if (tid < 256) {
            const int i = tid >> 4, j = tid & 15;
            float v = sK0[(0 * 16 + i) * 16 + j] + sK0[(1 * 16 + i) * 16 + j];
            if (i == j) v += p.in[I_SSMD][l * 512 + g * 16 + i];
            tt[(size_t)63 * 256 + i * 16 + j] = f2bf(v);
        }
    } else if (sub == 1) {
        bf16_t* bt = reinterpret_cast<bf16_t*>(p.ws + WS_BT1) + (size_t)lg * 256 * 1024;
        for (int task = tid; task < 128 * 64; task += NTHREADS) {
            const int s = task & 63, dp = task >> 6, d = dp >> 6, pp = dp & 63;
            const int e = d == 0 ? 63 - s : s;
            float pr, pi;
            cpow(sLm[dp], sTh[dp], e, pr, pi);
            unsigned re8[8], im8[8];
#pragma unroll
            for (int j2 = 0; j2 < 8; ++j2) {
                float b0r = sBb[(dp * 16 + 2 * j2) * 2], b0i = sBb[(dp * 16 + 2 * j2) * 2 + 1];
                float b1r = sBb[(dp * 16 + 2 * j2 + 1) * 2], b1i = sBb[(dp * 16 + 2 * j2 + 1) * 2 + 1];
                re8[j2] = pack2(pr * b0r - pi * b0i, pr * b1r - pi * b1i);
                im8[j2] = pack2(pr * b0i + pi * b0r, pr * b1i + pi * b1r);
            }
            const int qre = d * 128 + 2 * pp, qim = qre + 1, ksb = s >> 1, fqb = (s & 1) * 2;
            bf16_t* dre = bt + ((size_t)((qre >> 4) * 32 + ksb) * 64 + fqb * 16 + (qre & 15)) * 8;
            bf16_t* dim_ = bt + ((size_t)((qim >> 4) * 32 + ksb) * 64 + fqb * 16 + (qim & 15)) * 8;
            *reinterpret_cast<uint4*>(dre) = make_uint4(re8[0], re8[1], re8[2], re8[3]);
            *reinterpret_cast<uint4*>(dre + 16 * 8) = make_uint4(re8[4], re8[5], re8[6], re8[7]);
            *reinterpret_cast<uint4*>(dim_) = make_uint4(im8[0], im8[1], im8[2], im8[3]);
            *reinterpret_cast<uint4*>(dim_ + 16 * 8) = make_uint4(im8[4], im8[5], im8[6], im8[7]);
        }
    } else {
        bf16_t* vt = reinterpret_cast<bf16_t*>(p.ws + WS_VT) + (size_t)lg * 1024 * 256;
        for (int task = tid; task < 64 * 128; task += NTHREADS) {
            const int dp = task & 127, t = task >> 7, d = dp >> 6, pp = dp & 63;
            const int e = d == 0 ? t + 1 : 64 - t;
            float pr, pi;
            cpow(sLm[dp], sTh[dp], e, pr, pi);
            for (int i = 0; i < 16; ++i) {
                float cr = sC[((d * 64 + pp) * 17 + i) * 2], ci = sC[((d * 64 + pp) * 17 + i) * 2 + 1];
                float xr = cr * pr - ci * pi, xi = cr * pi + ci * pr;
                {
                    const int q = d * 128 + 2 * pp;
                    *reinterpret_cast<unsigned*>(vt + ((size_t)(t * 8 + (q >> 5)) * 64 + ((q >> 3) & 3) * 16 + i) * 8 + (q & 7)) = pack2(xr, -xi);
                }
            }
        }
        if (tid < 128) {
            float re, im;
            cpow(sLm[tid], sTh[tid], 64, re, im);
            const int d = tid >> 6, pp = tid & 63;
            float* lt = reinterpret_cast<float*>(p.ws + WS_LAMT);
            lt[(((l * 2 + d) * 32 + g) * 64 + pp) * 2 + 0] = re;
            lt[(((l * 2 + d) * 32 + g) * 64 + pp) * 2 + 1] = im;
        }
    }
    __syncthreads();
}

__device__ __forceinline__ void pro_fold(const Params& p, int item, char* smem, const int tid) {
    const int nc = item & 7, g = (item >> 3) & 3, l = item >> 5;
    float* sA = reinterpret_cast<float*>(smem);
    float* sB = sA + 128 * 132;
    const float* wpl = p.in[I_WPOOL] + (size_t)(l * 4 + g) * 128 * 128;
    const float* spl = p.in[I_SPOOL] + l * 512 + g * 128;
    const float* wo = p.in[I_WOUT] + ((size_t)l * 1024 + g * 128) * 1024 + nc * 128;
    __syncthreads();
    {
        f32x4 av[8], bv[8];
        const f32x4 sc = *reinterpret_cast<const f32x4*>(spl + (tid & 31) * 4);
#pragma unroll
        for (int i = 0; i < 8; ++i) {
            const int r = (tid >> 5) + i * 16, c4 = (tid & 31) * 4;
            av[i] = *reinterpret_cast<const f32x4*>(wpl + r * 128 + c4);
            bv[i] = *reinterpret_cast<const f32x4*>(wo + (size_t)r * 1024 + c4);
        }
        __builtin_amdgcn_sched_barrier(0);
#pragma unroll
        for (int i = 0; i < 8; ++i) {
            const int r = (tid >> 5) + i * 16, c4 = (tid & 31) * 4;
            *reinterpret_cast<f32x4*>(sA + r * 132 + c4) = av[i] * sc;
            *reinterpret_cast<f32x4*>(sB + r * 132 + c4) = bv[i];
        }
    }
    __syncthreads();
    const int lane = tid & 63, wid = tid >> 6, ij = lane & 15, kq = lane >> 4;
    f32x4 acc[8];
#pragma unroll
    for (int t = 0; t < 8; ++t) acc[t] = f32x4{0.f, 0.f, 0.f, 0.f};
#pragma unroll 4
    for (int ks = 0; ks < 32; ++ks) {
        const float a = sA[(wid * 16 + ij) * 132 + ks * 4 + kq];
#pragma unroll
        for (int t = 0; t < 8; ++t) {
            const float b = sB[(ks * 4 + kq) * 132 + t * 16 + ij];
            acc[t] = __builtin_amdgcn_mfma_f32_16x16x4f32(a, b, acc[t], 0, 0, 0);
        }
    }
    bf16_t* wt = reinterpret_cast<bf16_t*>(p.ws + WS_WOUTT) + (size_t)l * 1024 * 1024;
#pragma unroll
    for (int t = 0; t < 8; ++t) {
        const int n = nc * 128 + t * 16 + ij, c = wid * 16 + kq * 4;
        *reinterpret_cast<uint2*>(wt + (size_t)n * 1024 + g * 128 + c) = make_uint2(pack2(acc[t][0], acc[t][1]), pack2(acc[t][2], acc[t][3]));
        {
            int q8 = __builtin_amdgcn_cvt_pk_fp8_f32(64.f * acc[t][0], 64.f * acc[t][1], 0, false);
            q8 = __builtin_amdgcn_cvt_pk_fp8_f32(64.f * acc[t][2], 64.f * acc[t][3], q8, true);
            *reinterpret_cast<int*>(p.ws + WS_WOUT8 + (size_t)l * 1024 * 1024 + (size_t)n * 1024 + g * 128 + c) = q8;
        }
    }
}

struct ConvDesc { const float* src; bf16_t* dst; int K, N, mode, k0, n0; };
__device__ __forceinline__ ConvDesc conv_desc(const Params& p, int tile) {
    ConvDesc d; int t; d.mode = 0;
    if (tile < 8192) {
        int m = tile >> 7; t = tile & 127; d.K = 1024; d.N = 512; d.mode = 1;
        d.src = p.in[I_WGATE] + (size_t)m * 1024 * 512; d.dst = reinterpret_cast<bf16_t*>(p.ws + WS_W1T + (size_t)m * 1024 * 1024);
    } else if (tile < 16384) {
        int u = tile - 8192; int m = u >> 7; t = u & 127; d.K = 1024; d.N = 512; d.mode = 2;
        d.src = p.in[I_WUP] + (size_t)m * 1024 * 512; d.dst = reinterpret_cast<bf16_t*>(p.ws + WS_W1T + (size_t)m * 1024 * 1024);
    } else if (tile < 24576) {
        int u = tile - 16384; int m = u >> 7; t = u & 127; d.K = 512; d.N = 1024; d.mode = 4;
        d.src = p.in[I_WDOWN] + (size_t)m * 512 * 1024; d.dst = reinterpret_cast<bf16_t*>(p.ws + WS_W2T + (size_t)m * 1024 * 512);
    } else if (tile < 25088) {
        int u = tile - 24576; int m = u >> 8; t = u & 255; d.K = 1024; d.N = 1024;
        d.src = p.in[I_WIN] + (size_t)m * 1024 * 1024; d.dst = reinterpret_cast<bf16_t*>(p.ws + WS_WINT) + (size_t)m * 1024 * 1024; d.mode = 5 + m;
    } else if (tile < 25600) {
        int u = tile - 25088; int m = u >> 8; t = u & 255; d.K = 1024; d.N = 1024;
        d.src = p.in[I_WOUT] + (size_t)m * 1024 * 1024; d.dst = reinterpret_cast<bf16_t*>(p.ws + WS_WOUTT) + (size_t)m * 1024 * 1024; d.mode = 7 + m;
    } else if (tile < 25728) {
        int u = tile - 25600; int m = u >> 6; t = u & 63; d.K = 512; d.N = 512;
        d.src = p.in[I_WGLU] + (size_t)m * 512 * 512; d.dst = reinterpret_cast<bf16_t*>(p.ws + WS_WGLUT) + (size_t)m * 512 * 512;
    } else {
        int u = tile - 25728; int m = u >> 2; t = u & 3; d.K = 128; d.N = 128;
        d.src = p.in[I_WPOOL] + (size_t)m * 128 * 128; d.dst = reinterpret_cast<bf16_t*>(p.ws + WS_WPOOLT) + (size_t)m * 128 * 128;
    }
    const int ntn = d.N / 64;
    d.k0 = (t / ntn) * 64; d.n0 = (t % ntn) * 64;
    if ((tile >= 25088 && tile < 25600 && d.k0 < 512) || tile >= 25728) d.mode = 3;
    return d;
}
__device__ __forceinline__ void conv_load(const ConvDesc& d, float4 (&v)[16], int lane) {
    if (d.mode == 3) return;
    const float* s0 = d.src + (size_t)(d.k0 + (lane & 3)) * d.N + d.n0 + (lane >> 2) * 4;
#pragma unroll
    for (int i = 0; i < 16; ++i) { const f32x4 q = __builtin_nontemporal_load(reinterpret_cast<const f32x4*>(s0 + (size_t)(4 * i) * d.N)); v[i] = make_float4(q[0], q[1], q[2], q[3]); }
}
__device__ __forceinline__ void conv_store(const ConvDesc& d, const float4 (&v)[16], float* t, int lane) {
    if (d.mode == 3) return;
    {
        float* tw = t + (lane & 3) * 65 + (lane >> 2) * 4;
#pragma unroll
        for (int i = 0; i < 16; ++i) {
            float* q = tw + 4 * i * 65;
            q[0] = v[i].x; q[1] = v[i].y; q[2] = v[i].z; q[3] = v[i].w;
        }
    }
    if (d.mode == 1 || d.mode == 2 || d.mode == 4) {
        const int kc = (lane >> 4) * 16;
#pragma unroll
        for (int it = 0; it < 4; ++it) {
            const int n = it * 16 + (lane & 15);
            const float* tr = t + kc * 65 + n;
            int q[4];
#pragma unroll
            for (int i = 0; i < 4; ++i) {
                q[i] = __builtin_amdgcn_cvt_pk_fp8_f32(64.f * tr[(4 * i) * 65], 64.f * tr[(4 * i + 1) * 65], 0, false);
                q[i] = __builtin_amdgcn_cvt_pk_fp8_f32(64.f * tr[(4 * i + 2) * 65], 64.f * tr[(4 * i + 3) * 65], q[i], true);
            }
            const int ng = d.n0 + n;
            const int nd = d.mode == 1 ? (ng >> 4) * 32 + (ng & 15) : d.mode == 2 ? (ng >> 4) * 32 + 16 + (ng & 15) : ng;
            __builtin_nontemporal_store(u32x4{(unsigned)q[0], (unsigned)q[1], (unsigned)q[2], (unsigned)q[3]},
                                        reinterpret_cast<u32x4*>(reinterpret_cast<unsigned char*>(d.dst) + (size_t)nd * d.K + d.k0 + kc));
        }
    } else {
        const int kc = (lane >> 3) * 8;
#pragma unroll
        for (int it = 0; it < 8; ++it) {
            const int n = it * 8 + (lane & 7);
            const float* tr = t + kc * 65 + n;
            unsigned o[4];
#pragma unroll
            for (int i = 0; i < 4; ++i) o[i] = pack2(tr[(2 * i) * 65], tr[(2 * i + 1) * 65]);
            const int ng = d.n0 + n;
            int nd = ng;
            if (d.mode == 1) nd = (ng >> 4) * 32 + (ng & 15);
            else if (d.mode == 2) nd = (ng >> 4) * 32 + 16 + (ng & 15);
            if (d.mode == 1 || d.mode == 2 || d.mode == 4) {
                int q0 = __builtin_amdgcn_cvt_pk_fp8_f32(64.f * tr[0 * 65], 64.f * tr[1 * 65], 0, false);
                q0 = __builtin_amdgcn_cvt_pk_fp8_f32(64.f * tr[2 * 65], 64.f * tr[3 * 65], q0, true);
                int q1 = __builtin_amdgcn_cvt_pk_fp8_f32(64.f * tr[4 * 65], 64.f * tr[5 * 65], 0, false);
                q1 = __builtin_amdgcn_cvt_pk_fp8_f32(64.f * tr[6 * 65], 64.f * tr[7 * 65], q1, true);
                __builtin_nontemporal_store(u32x2{(unsigned)q0, (unsigned)q1}, reinterpret_cast<u32x2*>(reinterpret_cast<unsigned char*>(d.dst) + (size_t)nd * d.K + d.k0 + kc));
            } else {
            *reinterpret_cast<uint4*>(d.dst + (size_t)nd * d.K + d.k0 + kc) = make_uint4(o[0], o[1], o[2], o[3]);
            if (d.mode >= 5) {
                int q0 = __builtin_amdgcn_cvt_pk_fp8_f32(64.f * tr[0 * 65], 64.f * tr[1 * 65], 0, false);
                q0 = __builtin_amdgcn_cvt_pk_fp8_f32(64.f * tr[2 * 65], 64.f * tr[3 * 65], q0, true);
                int q1 = __builtin_amdgcn_cvt_pk_fp8_f32(64.f * tr[4 * 65], 64.f * tr[5 * 65], 0, false);
                q1 = __builtin_amdgcn_cvt_pk_fp8_f32(64.f * tr[6 * 65], 64.f * tr[7 * 65], q1, true);
                unsigned char* d8 = reinterpret_cast<unsigned char*>(d.dst) + (d.mode >= 7 ? ((ptrdiff_t)WS_WOUT8 - (ptrdiff_t)WS_WOUTT) - (ptrdiff_t)(d.mode - 7) * 1024 * 1024
                                                                                           : ((ptrdiff_t)WS_WIN8 - (ptrdiff_t)WS_WINT) - (ptrdiff_t)(d.mode - 5) * 1024 * 1024);
                *reinterpret_cast<uint2*>(d8 + (size_t)nd * 1024 + d.k0 + kc) = make_uint2((unsigned)q0, (unsigned)q1);
            }
            }
        }
    }
}

__device__ __forceinline__ int conv_index_tile(int kind, int i) {
    int layer = kind;
    if (kind == 0) {
        if (i >= 18432) return 24576 + (i - 18432);
        if (i >= 12288) { layer = 1; i = i - 12288 + 6144; }
    }
    const int type = i >> 12, idx = i & 4095;
    return type * 8192 + (((layer * 32 + (idx >> 7)) << 7) | (idx & 127));
}
__device__ __forceinline__ void conv_wave_loop(const Params& p, int kind, int first, int stride, int end, float* t, int lane) {
    int tA = first;
    float4 va[16], vb[16];
    ConvDesc da, db;
    if (tA < end) { da = conv_desc(p, conv_index_tile(kind, tA)); conv_load(da, va, lane); }
    while (tA < end) {
        const int tB = tA + stride;
        if (tB < end) { db = conv_desc(p, conv_index_tile(kind, tB)); conv_load(db, vb, lane); }
        conv_store(da, va, t, lane);
        tA = tB + stride;
        if (tA < end) { da = conv_desc(p, conv_index_tile(kind, tA)); conv_load(da, va, lane); }
        if (tB < end) conv_store(db, vb, t, lane);
    }
}

__device__ __forceinline__ void phase_prologue(const Params& p, int bid, int nb, char* smem, const int tid, const int parts = 7) {
    if (bid == 0) reinterpret_cast<int*>(p.ws + WS_CNT)[tid * CNT_STRIDE] = 0;
    constexpr int N_GEMV = 256, N_SSM = 2 * 32 * 3, N_CONV = 25760;
    constexpr int N_FOLD = 64;
    for (int it = bid; it < N_GEMV + N_SSM + N_FOLD; it += nb) {
        if (it < N_GEMV) { if (parts & 1) pro_gemv(p, it, smem, tid); }
        else if (it < N_GEMV + N_SSM) { if (parts & 2) pro_ssm(p, it - N_GEMV, smem, tid); }
        else pro_fold(p, it - N_GEMV - N_SSM, smem, tid);
    }
    __syncthreads();
    if (parts & 4) {
        const int lane = tid & 63, wid = tid >> 6;
        float* t = reinterpret_cast<float*>(smem) + wid * (64 * 65);
        constexpr int N_PRO = 18432 + (N_CONV - 24576);
        if (nb == 256) {
            constexpr int SPLIT = N_SSM * 8 * 9;
            if (bid < N_SSM) conv_wave_loop(p, 0, wid * N_SSM + bid, N_SSM * 8, SPLIT, t, lane);
            else conv_wave_loop(p, 0, SPLIT + wid * (256 - N_SSM) + (bid - N_SSM), (256 - N_SSM) * 8, N_PRO, t, lane);
        } else conv_wave_loop(p, 0, wid * nb + bid, nb * 8, N_PRO, t, lane);
    }
}

__device__ __forceinline__ const float* mod_ptr(const Params& p, int l, int v, int which) {
    return reinterpret_cast<const float*>(p.ws + WS_MOD) + (l * 2 + v) * 6144 + which * 1024;
}

__device__ __forceinline__ void phase_norm0(const Params& p, int bid, int nb, char* smem, const int tid) {
    const int lane = tid & 63, wid = tid >> 6;
    {
        float* wp = reinterpret_cast<float*>(p.ws + WS_WPRIME);
        float* gp = reinterpret_cast<float*>(p.ws + WS_GP);
        const float* wrt = p.in[I_WROUTER];
        for (int idx = bid * NTHREADS + tid; idx < 4 * 32768; idx += nb * NTHREADS) {
            const int lv = idx >> 15, k = (idx >> 5) & 1023;
            const float g = p.in[I_GFFN][(lv >> 1) * 1024 + k] * (1.f + mod_ptr(p, lv >> 1, lv & 1, 4)[k]);
            {
                const int e = idx & 31, ks = k >> 5, ln = ((k >> 3) & 3) * 16 + (e & 15), half = e >> 4;
                const float v = g * wrt[idx & 32767];
                const unsigned hi = pack2(v, 0.f) & 0xFFFFu;
                const unsigned lo = pack2(v - __uint_as_float(hi << 16), 0.f) & 0xFFFFu;
                bf16_t* w16 = reinterpret_cast<bf16_t*>(wp) + (size_t)lv * 65536;
                w16[((((ks * 2 + 0) * 2 + half) * 64 + ln) * 8) + (k & 7)] = (bf16_t)hi;
                w16[((((ks * 2 + 1) * 2 + half) * 64 + ln) * 8) + (k & 7)] = (bf16_t)lo;
            }
            if ((idx & 31) == 0) gp[lv * 1024 + k] = g;
        }
        if (bid < 4) {
            const int lv = bid, e = tid & 31, part = tid >> 5;
            const float* sh = mod_ptr(p, lv >> 1, lv & 1, 3);
            float a = 0.f;
#pragma unroll
            for (int kb = 0; kb < 64; kb += 32) {
                float wv[32], sv[32];
#pragma unroll
                for (int k = 0; k < 32; ++k) { wv[k] = wrt[(part * 64 + kb + k) * 32 + e]; sv[k] = sh[part * 64 + kb + k]; }
                __builtin_amdgcn_sched_barrier(0);
#pragma unroll
                for (int k = 0; k < 32; ++k) a = fmaf(sv[k], wv[k], a);
            }
            float* red = reinterpret_cast<float*>(smem);
            __syncthreads();
            red[tid] = a;
            __syncthreads();
            if (tid < 32) {
                float t = 0.f;
                for (int q = 0; q < 16; ++q) t += red[q * 32 + tid];
                reinterpret_cast<float*>(p.ws + WS_RB)[lv * 32 + tid] = t;
            }
        }
    }
    bf16_t* hA = reinterpret_cast<bf16_t*>(p.ws + WS_HA);
    const float* gm = p.in[I_GMIX];
#pragma unroll 1
    for (int v = 0; v < 2; ++v) {
        const int rbeg = v == 0 ? 0 : SEQ, rend = v == 0 ? SEQ : ROWS;
        const float* sh = mod_ptr(p, 0, v, 0);
        const float* sc = mod_ptr(p, 0, v, 1);
        float4 ga[4], bb[4];
#pragma unroll
        for (int i = 0; i < 4; ++i) {
            const int k = i * 256 + lane * 4;
            const float4 g = *reinterpret_cast<const float4*>(gm + k);
            const float4 a = *reinterpret_cast<const float4*>(sc + k);
            ga[i] = make_float4(g.x * (1.f + a.x), g.y * (1.f + a.y), g.z * (1.f + a.z), g.w * (1.f + a.w));
            bb[i] = *reinterpret_cast<const float4*>(sh + k);
        }
        const float* base = v == 0 ? p.in[I_X] : p.in[I_CTX] - (size_t)SEQ * 1024;
        const int stride = nb * 8;
#pragma unroll 1
        for (int r = rbeg + bid * 8 + wid; r < rend; r += 2 * stride) {
            const int r2 = r + stride;
            const bool has2 = r2 < rend;
            const float* s0 = base + (size_t)r * 1024 + lane * 4;
            const float* s1 = base + (size_t)(has2 ? r2 : r) * 1024 + lane * 4;
            float4 x0[4], x1[4];
#pragma unroll
            for (int i = 0; i < 4; ++i) { x0[i] = *reinterpret_cast<const float4*>(s0 + i * 256); x1[i] = *reinterpret_cast<const float4*>(s1 + i * 256); }
            float q0 = 0.f, q1 = 0.f;
#pragma unroll
            for (int i = 0; i < 4; ++i) {
                q0 += x0[i].x * x0[i].x + x0[i].y * x0[i].y + x0[i].z * x0[i].z + x0[i].w * x0[i].w;
                q1 += x1[i].x * x1[i].x + x1[i].y * x1[i].y + x1[i].z * x1[i].z + x1[i].w * x1[i].w;
            }
            q0 = wave_sum(q0); q1 = wave_sum(q1);
            const float rs0 = rsqrtf(q0 * (1.f / 1024.f) + 1e-6f), rs1 = rsqrtf(q1 * (1.f / 1024.f) + 1e-6f);
#pragma unroll
            for (int i = 0; i < 4; ++i) {
                const int k = i * 256 + lane * 4;
                const float a0 = x0[i].x * rs0 * ga[i].x + bb[i].x, a1 = x0[i].y * rs0 * ga[i].y + bb[i].y, a2 = x0[i].z * rs0 * ga[i].z + bb[i].z, a3 = x0[i].w * rs0 * ga[i].w + bb[i].w;
                const float c0 = x1[i].x * rs1 * ga[i].x + bb[i].x, c1 = x1[i].y * rs1 * ga[i].y + bb[i].y, c2 = x1[i].z * rs1 * ga[i].z + bb[i].z, c3 = x1[i].w * rs1 * ga[i].w + bb[i].w;
                if (v == 0) {
                    int q8 = __builtin_amdgcn_cvt_pk_fp8_f32(a0, a1, 0, false);
                    q8 = __builtin_amdgcn_cvt_pk_fp8_f32(a2, a3, q8, true);
                    *reinterpret_cast<int*>(reinterpret_cast<unsigned char*>(hA) + (size_t)r * 1024 + k) = q8;
                    if (has2) {
                        int p8 = __builtin_amdgcn_cvt_pk_fp8_f32(c0, c1, 0, false);
                        p8 = __builtin_amdgcn_cvt_pk_fp8_f32(c2, c3, p8, true);
                        *reinterpret_cast<int*>(reinterpret_cast<unsigned char*>(hA) + (size_t)r2 * 1024 + k) = p8;
                    }
                } else {
                    bf16_t* hc = reinterpret_cast<bf16_t*>(p.ws + WS_HACTX);
                    *reinterpret_cast<uint2*>(hc + (size_t)(r - SEQ) * 1024 + k) = make_uint2(pack2(a0, a1), pack2(a2, a3));
                    if (has2) *reinterpret_cast<uint2*>(hc + (size_t)(r2 - SEQ) * 1024 + k) = make_uint2(pack2(c0, c1), pack2(c2, c3));
                }
            }
        }
    }
}

__device__ __forceinline__ void phase_win(const Params& p, int l, int bid, int nb, char* smem, const int tid) {
    const bf16_t* hA = reinterpret_cast<const bf16_t*>(p.ws + WS_HA);
    const bf16_t* wt = reinterpret_cast<const bf16_t*>(p.ws + WS_WINT) + (size_t)l * 1024 * 1024;
    bf16_t* ux = reinterpret_cast<bf16_t*>(p.ws + WS_UX);
    for (int tile = bid; tile < 256; tile += nb) {
        const int xcd = tile & 7, jj = tile >> 3;
        const int mt = xcd * 8 + (jj >> 2), nt = jj & 3;
        f32x4 acc[2][2][4][2];
        const int et = gemm256<true>(acc, p.ws, WS_HA, [&](int r) { return (mt * 256 + r) * 1024; }, WS_WIN8 + ((size_t)(l * 1024 + nt * 256) * 1024), 1024, 1024, smem, tid);
        const int lane = et & 63, wid = et >> 6, wr = wid >> 2, wc = wid & 3, fr = lane & 15, fq = lane >> 4;
        if (nt >= 2) {
            store_tile_ssm(smem, et,
                [&](int ai, int bj, int m, int n) { const f32x4 a = acc[ai][bj][m][n]; return make_uint2(pack2(a[0], a[1]), pack2(a[2], a[3])); },
                ux, mt * 256, nt - 2);
        } else {
            constexpr int TS = 520;
#pragma unroll
            for (int ai = 0; ai < 2; ++ai)
#pragma unroll
                for (int bj = 0; bj < 2; ++bj)
#pragma unroll
                    for (int m = 0; m < 4; ++m)
#pragma unroll
                        for (int n = 0; n < 2; ++n) {
                            const int rl = ai * 128 + wr * 64 + m * 16 + fr, cl = bj * 128 + wc * 32 + n * 16 + fq * 4;
                            const f32x4 a = acc[ai][bj][m][n];
                            *reinterpret_cast<uint2*>(smem + rl * TS + cl * 2) = make_uint2(pack2(a[0], a[1]), pack2(a[2], a[3]));
                        }
            __syncthreads();
            {
                const int cp = et & 127, seg = et >> 7;
                const int gsel = nt * 2 + (cp >> 6);
                const char* rbase = smem + (seg * 64) * TS + cp * 4;
                unsigned char* mixo = p.ws + WS_MIX + (size_t)(mt * 256 + seg * 64) * 1024 + nt * 256 + cp * 2;
                unsigned cv[64];
#pragma unroll
                for (int t = 0; t < 64; ++t) cv[t] = *reinterpret_cast<const unsigned*>(rbase + t * TS);
                __builtin_amdgcn_sched_barrier(0);
                auto slide = [&](auto hwc) {
                    constexpr int HW = decltype(hwc)::value;
                    float s0 = 0.f, s1 = 0.f;
#pragma unroll
                    for (int q = 0; q < HW; ++q) { s0 += bf2f((unsigned short)(cv[q] & 0xFFFF)); s1 += bf2f((unsigned short)(cv[q] >> 16)); }
#pragma unroll
                    for (int t = 0; t < 64; ++t) {
                        const int lo = t - HW > 0 ? t - HW : 0, hi = t + HW < 64 ? t + HW : 64;
                        const float inv = 1.f / (float)(hi - lo);
                        const unsigned u = cv[t];
                        *reinterpret_cast<unsigned short*>(mixo + (size_t)t * 1024) = (unsigned short)__builtin_amdgcn_cvt_pk_fp8_f32(s0 * inv - bf2f((unsigned short)(u & 0xFFFF)), s1 * inv - bf2f((unsigned short)(u >> 16)), 0, false);
                        if (t + HW < 64) { const unsigned a = cv[t + HW < 64 ? t + HW : 0]; s0 += bf2f((unsigned short)(a & 0xFFFF)); s1 += bf2f((unsigned short)(a >> 16)); }
                        if (t - HW >= 0) { const unsigned b = cv[t - HW >= 0 ? t - HW : 0]; s0 -= bf2f((unsigned short)(b & 0xFFFF)); s1 -= bf2f((unsigned short)(b >> 16)); }
                    }
                };
                if (gsel == 0) slide(std::integral_constant<int, 1>{});
                else if (gsel == 1) slide(std::integral_constant<int, 2>{});
                else if (gsel == 2) slide(std::integral_constant<int, 4>{});
                else slide(std::integral_constant<int, 8>{});
            }
            __syncthreads();
        }
    }
    const int coloff = l == 1 ? 512 : 0;
    const int ncb = (1024 - coloff) / 32;
    for (int it = bid; it < 8 * ncb; it += nb) {
        const int mb = it / ncb, nbk = it % ncb;
        mini_gemm(reinterpret_cast<const bf16_t*>(p.ws + WS_HACTX), 1024, wt + (size_t)coloff * 1024, 1024, 1024, mb, nbk, smem, tid,
                  [&](int r, int c, float v0, float v1) {
                      const int ca = coloff + c;
                      bf16_t* dst = ca < 512 ? ux + (size_t)(SEQ + r) * 1024 + ca : ux + ((size_t)((ca - 512) >> 4) * ROWS + SEQ + r) * 16 + ((ca - 512) & 15);
                      *reinterpret_cast<unsigned*>(dst) = pack2(v0, v1); });
    }
}

__device__ __forceinline__ void ssm_load_u(const Params& p, int g, int c0, int nvalid, char* sU, const int tid) {
    const bf16_t* ux = reinterpret_cast<const bf16_t*>(p.ws + WS_UX);
    for (int pc = tid; pc < 2048; pc += NTHREADS) {
        const int half = pc & 1, s = (pc >> 1) & 63, cc = pc >> 7;
        const int c = c0 + (cc < nvalid ? cc : nvalid - 1);
        uint4 v = *reinterpret_cast<const uint4*>(ux + (size_t)(c * 64 + s) * 1024 + 512 + g * 16 + half * 8);
        *reinterpret_cast<uint4*>(sU + cc * 2064 + s * 32 + half * 16) = v;
    }
}


__device__ __forceinline__ void ssm_load_u32(const Params& p, int g, int c0, char* sU, const int tid) {
    const bf16_t* ux = reinterpret_cast<const bf16_t*>(p.ws + WS_UX);
    u32x4 v[8];
#pragma unroll
    for (int i = 0; i < 8; ++i) {
        const int pc = tid + i * NTHREADS;
        const int half = pc & 1, sx = (pc >> 1) & 63, cc = pc >> 7;
        v[i] = *reinterpret_cast<const u32x4*>(ux + ((size_t)g * ROWS + (c0 + cc) * 64 + sx) * 16 + half * 8);
    }
    __builtin_amdgcn_sched_barrier(0);
#pragma unroll
    for (int i = 0; i < 8; ++i) {
        const int pc = tid + i * NTHREADS;
        const int half = pc & 1, sx = (pc >> 1) & 63, cc = pc >> 7;
        *reinterpret_cast<u32x4*>(sU + cc * 2064 + sx * 32 + half * 16) = v[i];
    }
    __builtin_amdgcn_sched_barrier(0);
}
__device__ __forceinline__ void ssm_load_uctx(const Params& p, int g, char* sUc, const int tid) {
    const bf16_t* ux = reinterpret_cast<const bf16_t*>(p.ws + WS_UX);
    const int half = tid & 1, sx = (tid >> 1) & 63, cc = tid >> 7;
    uint4 v = *reinterpret_cast<const uint4*>(ux + ((size_t)g * ROWS + (NXCH + cc) * 64 + sx) * 16 + half * 8);
    *reinterpret_cast<uint4*>(sUc + cc * 2064 + sx * 32 + half * 16) = v;
}

__device__ __forceinline__ void phase_s1(const Params& p, int l, int bid, int nb, char* smem, const int tid) {
    const int lane = tid & 63, wid = __builtin_amdgcn_readfirstlane(tid >> 6), fr = lane & 15, fq = lane >> 4;
    const bool last = (l == 1);
    char* sU = smem;
    char* sUc = smem + 66048;
    float* sL = reinterpret_cast<float*>(smem + 66048 + 8256);
    float* sLc = sL + 32 * 256;
    float* HLOC = reinterpret_cast<float*>(p.ws + WS_L);
    float* EAGG = reinterpret_cast<float*>(p.ws + WS_EAGG);
    float* ECTX = reinterpret_cast<float*>(p.ws + WS_ECTX);
    bf16_t* HIN = reinterpret_cast<bf16_t*>(p.ws + WS_HIN);
    for (int it = bid; it < 256; it += nb) {
        const int g = (it & 7) * 4 + (it >> 6), k = (it >> 3) & 7, c0 = k * 32;
        __syncthreads();
        ssm_load_u32(p, g, c0, sU, tid);
        ssm_load_uctx(p, g, sUc, tid);
        __syncthreads();
        const bf16_t* bt = reinterpret_cast<const bf16_t*>(p.ws + WS_BT1) + (size_t)(l * 32 + g) * 256 * 1024 + ((size_t)(wid * 2) * 32 * 64 + lane) * 8;
        f32x4 acc[2][2], accc[2];
#pragma unroll
        for (int a = 0; a < 2; ++a) { accc[a] = f32x4{0, 0, 0, 0}; acc[a][0] = f32x4{0, 0, 0, 0}; acc[a][1] = f32x4{0, 0, 0, 0}; }
        const bool doctx = (wid == k);
#pragma unroll 1
        for (int kb = 0; kb < 32; kb += 8) {
            bf16x8 b0[8], b1[8];
#pragma unroll
            for (int i = 0; i < 8; ++i) {
                b0[i] = *reinterpret_cast<const bf16x8*>(bt + (kb + i) * 512);
                b1[i] = *reinterpret_cast<const bf16x8*>(bt + 32 * 512 + (kb + i) * 512);
            }
            __builtin_amdgcn_sched_barrier(0);
#pragma unroll
            for (int i = 0; i < 8; ++i) {
                const int ks = kb + i;
                const bf16x8 a0 = *reinterpret_cast<const bf16x8*>(sU + fr * 2064 + ks * 64 + fq * 16);
                const bf16x8 a1 = *reinterpret_cast<const bf16x8*>(sU + (16 + fr) * 2064 + ks * 64 + fq * 16);
                acc[0][0] = __builtin_amdgcn_mfma_f32_16x16x32_bf16(b0[i], a0, acc[0][0], 0, 0, 0);
                acc[0][1] = __builtin_amdgcn_mfma_f32_16x16x32_bf16(b1[i], a0, acc[0][1], 0, 0, 0);
                acc[1][0] = __builtin_amdgcn_mfma_f32_16x16x32_bf16(b0[i], a1, acc[1][0], 0, 0, 0);
                acc[1][1] = __builtin_amdgcn_mfma_f32_16x16x32_bf16(b1[i], a1, acc[1][1], 0, 0, 0);
                if (doctx) {
                    const bf16x8 ac = *reinterpret_cast<const bf16x8*>(sUc + (fr & 3) * 2064 + ks * 64 + fq * 16);
                    accc[0] = __builtin_amdgcn_mfma_f32_16x16x32_bf16(b0[i], ac, accc[0], 0, 0, 0);
                    accc[1] = __builtin_amdgcn_mfma_f32_16x16x32_bf16(b1[i], ac, accc[1], 0, 0, 0);
                }
            }
            __builtin_amdgcn_sched_barrier(0);
        }
#pragma unroll
        for (int mt = 0; mt < 2; ++mt)
#pragma unroll
            for (int nn = 0; nn < 2; ++nn)
                *reinterpret_cast<float4*>(sL + (mt * 16 + fr) * 256 + wid * 32 + nn * 16 + fq * 4) = make_float4(acc[mt][nn][0], acc[mt][nn][1], acc[mt][nn][2], acc[mt][nn][3]);
        if (doctx && fr < 4) {
#pragma unroll
            for (int nn = 0; nn < 2; ++nn)
                *reinterpret_cast<float4*>(sLc + fr * 32 + nn * 16 + fq * 4) = make_float4(accc[nn][0], accc[nn][1], accc[nn][2], accc[nn][3]);
        }
        __syncthreads();
        if (tid < 128) {
            const int d = tid >> 6, pp = tid & 63, q = d * 128 + 2 * pp;
            const float* lt = reinterpret_cast<const float*>(p.ws + WS_LAMT) + (((l * 2 + d) * 32 + g) * 64 + pp) * 2;
            const float ar = lt[0], ai = lt[1];
            float hr = 0.f, hi = 0.f;
#pragma unroll 4
            for (int j = 0; j < 32; ++j) {
                const int cj = d == 0 ? j : 31 - j;
                *reinterpret_cast<float2*>(HLOC + ((size_t)(c0 + cj) * 32 + g) * 256 + q) = make_float2(hr, hi);
                const float2 lv = *reinterpret_cast<const float2*>(sL + cj * 256 + q);
                const float nr = ar * hr - ai * hi + lv.x, ni = ar * hi + ai * hr + lv.y;
                hr = nr; hi = ni;
            }
            *reinterpret_cast<float2*>(EAGG + ((size_t)g * 8 + k) * 256 + q) = make_float2(hr, hi);
        } else if (tid < 144) {
            const int sx = tid - 128, q = 32 * k + 2 * sx, d = k >> 2, pp = (q & 127) >> 1;
            const float* lt = reinterpret_cast<const float*>(p.ws + WS_LAMT) + (((l * 2 + d) * 32 + g) * 64 + pp) * 2;
            const float ar = lt[0], ai = lt[1];
            float hr = 0.f, hi = 0.f;
#pragma unroll
            for (int j = 0; j < 4; ++j) {
                const int cj = d == 0 ? j : 3 - j;
                *reinterpret_cast<unsigned*>(HIN + ((size_t)(NXCH + cj) * 32 + g) * 256 + q) = pack2(hr, hi);
                const float2 lv = *reinterpret_cast<const float2*>(sLc + cj * 32 + 2 * sx);
                const float nr = ar * hr - ai * hi + lv.x, ni = ar * hi + ai * hr + lv.y;
                hr = nr; hi = ni;
            }
            *reinterpret_cast<float2*>(ECTX + (size_t)g * 256 + q) = make_float2(hr, hi);
        }
    }
    if (!last) {
        const unsigned* ux32 = reinterpret_cast<const unsigned*>(p.ws + WS_UX);
        bf16_t* pd = reinterpret_cast<bf16_t*>(p.ws + WS_MIX);
        for (int t = bid; t < CTXL; t += nb) {
            if (tid < 256) {
                const int cp = tid, h = 1 << (cp >> 6);
                const int lo = max(t - h, 0), hi = min(t + h, CTXL);
                const unsigned* col = ux32 + (size_t)SEQ * 512 + cp;
                unsigned v[16];
#pragma unroll
                for (int d = 0; d < 16; ++d) { const int q = lo + d; v[d] = col[(size_t)(q < hi ? q : lo) * 512]; }
                const unsigned uc = col[(size_t)t * 512];
                float s0 = 0.f, s1 = 0.f;
#pragma unroll
                for (int d = 0; d < 16; ++d)
                    if (lo + d < hi) { s0 += bf2f((unsigned short)(v[d] & 0xFFFF)); s1 += bf2f((unsigned short)(v[d] >> 16)); }
                const float inv = 1.f / (float)(hi - lo);
                const float o0 = s0 * inv - bf2f((unsigned short)(uc & 0xFFFF)), o1 = s1 * inv - bf2f((unsigned short)(uc >> 16));
                *reinterpret_cast<unsigned*>(pd + (size_t)(SEQ + t) * 1024 + cp * 2) = pack2(o0, o1);
            }
        }
    }
}

__device__ __forceinline__ void ttab_stage(const Params& p, int l, int g, char* sT, const int t, const int nthr) {
    const u32x4* src = reinterpret_cast<const u32x4*>(p.ws + WS_TTAB + (size_t)(l * 32 + g) * 128 * 512);
#pragma unroll 1
    for (int i0 = 0; i0 < 4064; i0 += 5 * nthr) {
        u32x4 tv[5];
#pragma unroll
        for (int i = 0; i < 5; ++i) { const int idx = i0 + t + i * nthr; tv[i] = src[idx < 4064 ? idx : 4063]; }
        __builtin_amdgcn_sched_barrier(0);
#pragma unroll
        for (int i = 0; i < 5; ++i) { const int idx = i0 + t + i * nthr; if (idx < 4064) reinterpret_cast<u32x4*>(sT)[idx] = tv[i]; }
        __builtin_amdgcn_sched_barrier(0);
    }
}
__device__ __forceinline__ void phase_s2(const Params& p, int l, int bid, int nb, char* smem, const int tid_in, const bool staged = false) {
    const bool last = (l == 1);
    char* sT = smem;
    char* sU = smem + 65536;
    char* sH = smem + 65536 + 66048;
    bf16_t* ysm = reinterpret_cast<bf16_t*>(p.ws + WS_YSM);
    const float* HLOC = reinterpret_cast<const float*>(p.ws + WS_L);
    const float* EAGG = reinterpret_cast<const float*>(p.ws + WS_EAGG);
    const float* ECTX = reinterpret_cast<const float*>(p.ws + WS_ECTX);
    const bf16_t* HIN = reinterpret_cast<const bf16_t*>(p.ws + WS_HIN);
    for (int it = bid; it < 256; it += nb) {
        int tid = tid_in;
        asm volatile("" : "+v"(tid));
        const int lane = tid & 63, wid = __builtin_amdgcn_readfirstlane(tid >> 6), fr = lane & 15, fq = lane >> 4;
        const int g = (it & 7) * 4 + (it >> 6), k = (it >> 3) & 7, c0 = k * 32;
        __syncthreads();
        if (!(staged && it == bid)) ttab_stage(p, l, g, sT, tid, NTHREADS);
        ssm_load_u32(p, g, c0, sU, tid);
        __syncthreads();
        const bf16_t* vt = reinterpret_cast<const bf16_t*>(p.ws + WS_VT) + (size_t)(l * 32 + g) * 1024 * 256 + ((size_t)(wid * 8) * 8 * 64 + lane) * 8;
        bf16x8 vb[3][8];
#pragma unroll
        for (int tt = 0; tt < 8; ++tt) { vb[0][tt] = *reinterpret_cast<const bf16x8*>(vt + (size_t)tt * 4096); vb[1][tt] = *reinterpret_cast<const bf16x8*>(vt + (size_t)tt * 4096 + 512); }
        if (tid < 128) {
            const int d = tid >> 6, pp = tid & 63, q = d * 128 + 2 * pp;
            const float* lt = reinterpret_cast<const float*>(p.ws + WS_LAMT) + (((l * 2 + d) * 32 + g) * 64 + pp) * 2;
            const float ar = lt[0], ai = lt[1];
            float br = ar, bi = ai;
#pragma unroll
            for (int i = 0; i < 5; ++i) { const float t = br * br - bi * bi; bi = 2.f * br * bi; br = t; }
            float2 e[8];
#pragma unroll
            for (int kk = 0; kk < 8; ++kk) e[kk] = *reinterpret_cast<const float2*>(EAGG + ((size_t)g * 8 + kk) * 256 + q);
            float2 hloc[32];
#pragma unroll
            for (int j = 0; j < 32; ++j) hloc[j] = *reinterpret_cast<const float2*>(HLOC + ((size_t)(c0 + j) * 32 + g) * 256 + q);
            const float2 ec = *reinterpret_cast<const float2*>(ECTX + (size_t)g * 256 + q);
            float hr = ec.x, hi = ec.y;
#pragma unroll
            for (int kk = 0; kk < 8; ++kk) {
                const int ki = d == 0 ? kk : 7 - kk;
                const bool use = d == 0 ? (ki < k) : (ki > k);
                if (use) { const float nr = br * hr - bi * hi + e[ki].x, ni = br * hi + bi * hr + e[ki].y; hr = nr; hi = ni; }
            }
            float pr = 1.f, pi = 0.f;
#pragma unroll
            for (int j = 0; j < 32; ++j) {
                const int cj = d == 0 ? j : 31 - j;
                const float vr = pr * hr - pi * hi + hloc[cj].x, vi = pr * hi + pi * hr + hloc[cj].y;
                *reinterpret_cast<unsigned*>(sH + cj * 528 + q * 2) = pack2(vr, vi);
                const float t = pr * ar - pi * ai; pi = pr * ai + pi * ar; pr = t;
            }
        }
        f32x4 acc[2][8];
#pragma unroll
        for (int mt = 0; mt < 2; ++mt)
#pragma unroll
            for (int tt = 0; tt < 8; ++tt) acc[mt][tt] = f32x4{0, 0, 0, 0};
        {
            bf16x8 fa[2][2], fb[2][8];
            auto ldfrag = [&](int ks, bf16x8 (&a)[2], bf16x8 (&b)[8]) {
                a[0] = *reinterpret_cast<const bf16x8*>(sU + fr * 2064 + ks * 64 + fq * 16);
                a[1] = *reinterpret_cast<const bf16x8*>(sU + (16 + fr) * 2064 + ks * 64 + fq * 16);
                const char* tb = sT + (wid * 8 - 2 * ks - (fq >> 1) + 63) * 512 + fr * 32 + (fq & 1) * 16;
#pragma unroll
                for (int tt = 0; tt < 8; ++tt) b[tt] = *reinterpret_cast<const bf16x8*>(tb + tt * 512);
            };
            auto mma = [&](const bf16x8 (&a)[2], const bf16x8 (&b)[8]) {
#pragma unroll
                for (int tt = 0; tt < 8; ++tt) {
                    acc[0][tt] = __builtin_amdgcn_mfma_f32_16x16x32_bf16(b[tt], a[0], acc[0][tt], 0, 0, 0);
                    acc[1][tt] = __builtin_amdgcn_mfma_f32_16x16x32_bf16(b[tt], a[1], acc[1][tt], 0, 0, 0);
                }
            };
            ldfrag(0, fa[0], fb[0]);
#pragma unroll 1
            for (int ks = 0; ks < 32; ks += 2) {
                ldfrag(ks + 1, fa[1], fb[1]);
                __builtin_amdgcn_sched_barrier(0);
                mma(fa[0], fb[0]);
                __builtin_amdgcn_sched_barrier(0);
                ldfrag(ks + 2 < 32 ? ks + 2 : 31, fa[0], fb[0]);
                __builtin_amdgcn_sched_barrier(0);
                mma(fa[1], fb[1]);
                __builtin_amdgcn_sched_barrier(0);
            }
        }
        __syncthreads();
#pragma unroll
        for (int ks = 0; ks < 8; ++ks) {
            if (ks + 2 < 8) {
#pragma unroll
                for (int tt = 0; tt < 8; ++tt) vb[(ks + 2) % 3][tt] = *reinterpret_cast<const bf16x8*>(vt + (size_t)tt * 4096 + (ks + 2) * 512);
            }
            __builtin_amdgcn_sched_barrier(0);
            const bf16x8 a0 = *reinterpret_cast<const bf16x8*>(sH + fr * 528 + ks * 64 + fq * 16);
            const bf16x8 a1 = *reinterpret_cast<const bf16x8*>(sH + (16 + fr) * 528 + ks * 64 + fq * 16);
#pragma unroll
            for (int tt = 0; tt < 8; ++tt) {
                acc[0][tt] = __builtin_amdgcn_mfma_f32_16x16x32_bf16(vb[ks % 3][tt], a0, acc[0][tt], 0, 0, 0);
                acc[1][tt] = __builtin_amdgcn_mfma_f32_16x16x32_bf16(vb[ks % 3][tt], a1, acc[1][tt], 0, 0, 0);
            }
            __builtin_amdgcn_sched_barrier(0);
        }
#pragma unroll
        for (int mt = 0; mt < 2; ++mt)
#pragma unroll
            for (int tt = 0; tt < 8; ++tt) {
                const int row = (c0 + mt * 16 + fr) * 64 + wid * 8 + tt;
                const f32x4 a = acc[mt][tt];
                *reinterpret_cast<uint2*>(ysm + (size_t)row * 512 + g * 16 + fq * 4) =
                    make_uint2(pack2(gelu_tanh(a[0]), gelu_tanh(a[1])), pack2(gelu_tanh(a[2]), gelu_tanh(a[3])));
            }
        if (!last) {
            __syncthreads();
            ssm_load_uctx(p, g, sU, tid);
            {
                const int cc = tid >> 5, i = tid & 31;
                if (tid < 128) {
                    uint4 v = *reinterpret_cast<const uint4*>(HIN + ((size_t)(NXCH + cc) * 32 + g) * 256 + i * 8);
                    *reinterpret_cast<uint4*>(sH + cc * 528 + i * 16) = v;
                }
            }
            __syncthreads();
            f32x4 ax = f32x4{0, 0, 0, 0};
            const int t = 8 * k + wid;
#pragma unroll 4
            for (int ks = 0; ks < 32; ++ks) {
                const bf16x8 a = *reinterpret_cast<const bf16x8*>(sU + (fr & 3) * 2064 + ks * 64 + fq * 16);
                const int sx = 2 * ks + (fq >> 1);
                const bf16x8 b = *reinterpret_cast<const bf16x8*>(sT + (t - sx + 63) * 512 + fr * 32 + (fq & 1) * 16);
                ax = __builtin_amdgcn_mfma_f32_16x16x32_bf16(b, a, ax, 0, 0, 0);
            }
            const bf16_t* vtc = reinterpret_cast<const bf16_t*>(p.ws + WS_VT) + (size_t)(l * 32 + g) * 1024 * 256 + ((size_t)t * 8 * 64 + lane) * 8;
            {
                bf16x8 bq[8];
#pragma unroll
                for (int ks = 0; ks < 8; ++ks) bq[ks] = *reinterpret_cast<const bf16x8*>(vtc + ks * 512);
                __builtin_amdgcn_sched_barrier(0);
#pragma unroll
                for (int ks = 0; ks < 8; ++ks) {
                    const bf16x8 a = *reinterpret_cast<const bf16x8*>(sH + (fr & 3) * 528 + ks * 64 + fq * 16);
                    ax = __builtin_amdgcn_mfma_f32_16x16x32_bf16(bq[ks], a, ax, 0, 0, 0);
                }
            }
            if (fr < 4) {
                const int row = (NXCH + fr) * 64 + t;
                *reinterpret_cast<uint2*>(ysm + (size_t)row * 512 + g * 16 + fq * 4) =
                    make_uint2(pack2(gelu_tanh(ax[0]), gelu_tanh(ax[1])), pack2(gelu_tanh(ax[2]), gelu_tanh(ax[3])));
            }
        }
    }
}

__device__ __forceinline__ void phase_glu_pool(const Params& p, int l, int bid, int nb, char* smem, const int tid) {
    const bool last = (l == 1);
    const bf16_t* ysm = reinterpret_cast<const bf16_t*>(p.ws + WS_YSM);
    bf16_t* mix = reinterpret_cast<bf16_t*>(p.ws + WS_MIX);
    const float* bg = p.in[I_BGLU] + l * 512;
    const bf16_t* pd = reinterpret_cast<const bf16_t*>(p.ws + WS_PD);
    const float* sp = p.in[I_SPOOL] + l * 512;
    for (int it = bid; it < 256; it += nb) {
        if (it < 128) {
            const int mt = it >> 1, nt = it & 1;
            f32x4 acc[2][2][4][2];
            const int et = gemm256<false>(acc, p.ws, WS_YSM, [&](int r) { return (mt * 256 + r) * 1024; }, WS_WGLUT + ((size_t)(l * 512 + nt * 256) * 512) * 2, 1024, 1024, smem, tid);
            const int lane = et & 63, wid = et >> 6, wr = wid >> 2, wc = wid & 3, fr = lane & 15, fq = lane >> 4;
            float4 b4[2][2];
#pragma unroll
            for (int bj = 0; bj < 2; ++bj)
#pragma unroll
                for (int n = 0; n < 2; ++n) b4[bj][n] = *reinterpret_cast<const float4*>(bg + nt * 256 + bj * 128 + wc * 32 + n * 16 + fq * 4);
            {
                const int half = lane >> 5, sl = lane & 31;
#pragma unroll 2
                for (int j = 0; j < 16; ++j) {
                    const int rl = (wid * 16 + j) * 2 + half;
                    __builtin_amdgcn_global_load_lds((const unsigned*)(ysm + (size_t)(mt * 256 + rl) * 512 + nt * 256 + ((sl ^ (rl & 15)) << 3)),
                                                     (LAS unsigned*)((LAS unsigned char*)smem + (wid * 16 + j) * 1024), 16, 0, 0);
                }
            }
            asm volatile("s_waitcnt vmcnt(0)" ::: "memory");
            __syncthreads();
#pragma unroll
            for (int ai = 0; ai < 2; ++ai)
#pragma unroll
                for (int bj = 0; bj < 2; ++bj)
#pragma unroll
                    for (int m = 0; m < 4; ++m)
#pragma unroll
                        for (int n = 0; n < 2; ++n) {
                            const int rl = ai * 128 + wr * 64 + m * 16 + fr;
                            const int row = mt * 256 + rl, col = nt * 256 + bj * 128 + wc * 32 + n * 16 + fq * 4;
                            const int slot = (bj * 16 + wc * 4 + n * 2 + (fq >> 1)) ^ fr;
                            const uint2 y = *reinterpret_cast<const uint2*>(smem + rl * 512 + slot * 16 + (fq & 1) * 8);
                            const f32x4 a = acc[ai][bj][m][n];
                            const float4 b = b4[bj][n];
                            const float y0 = bf2f((unsigned short)(y.x & 0xFFFF)), y1 = bf2f((unsigned short)(y.x >> 16));
                            const float y2 = bf2f((unsigned short)(y.y & 0xFFFF)), y3 = bf2f((unsigned short)(y.y >> 16));
                            const float o0 = y0 * sigmoidf_fast(a[0] + b.x), o1 = y1 * sigmoidf_fast(a[1] + b.y);
                            const float o2 = y2 * sigmoidf_fast(a[2] + b.z), o3 = y3 * sigmoidf_fast(a[3] + b.w);
                            {
                                int q8 = __builtin_amdgcn_cvt_pk_fp8_f32(o0, o1, 0, false);
                                q8 = __builtin_amdgcn_cvt_pk_fp8_f32(o2, o3, q8, true);
                                *reinterpret_cast<int*>(smem + rl * 512 + slot * 16 + (fq & 1) * 8) = q8;
                                (void)row; (void)col;
                            }
                        }
            __syncthreads();
            {
                unsigned char* mix8 = reinterpret_cast<unsigned char*>(mix);
#pragma unroll 4
                for (int k = 0; k < 16; ++k) {
                    const int rl2 = k * 16 + wid * 2 + (lane >> 5), sl = lane & 31;
                    const u32x4 v = *reinterpret_cast<const u32x4*>(smem + rl2 * 512 + sl * 16);
                    *reinterpret_cast<uint2*>(mix8 + (size_t)(mt * 256 + rl2) * 1024 + 512 + nt * 256 + ((sl ^ (rl2 & 15)) << 3)) = make_uint2(v[0], v[2]);
                }
            }
            __syncthreads();
        } else {
            int tid2 = tid;
            asm volatile("" : "+v"(tid2));
            if (!last) {
            const bf16_t* wt = reinterpret_cast<const bf16_t*>(p.ws + WS_WGLUT) + (size_t)l * 512 * 512;
            const int i2 = it - 128;
            const int mb = i2 >> 4, nbk = i2 & 15;
            mini_gemm(ysm + (size_t)SEQ * 512, 512, wt, 512, 512, mb, nbk, smem, tid2, [&](int r, int c, float v0, float v1) {
                const unsigned yv = *reinterpret_cast<const unsigned*>(ysm + (size_t)(SEQ + r) * 512 + c);
                const float y0 = bf2f((unsigned short)(yv & 0xFFFF)), y1 = bf2f((unsigned short)(yv >> 16));
                *reinterpret_cast<unsigned*>(mix + (size_t)(SEQ + r) * 1024 + 512 + c) =
                    pack2(y0 * sigmoidf_fast(v0 + bg[c]), y1 * sigmoidf_fast(v1 + bg[c + 1]));
            });
            }
            {
                __syncthreads();
                int tid3 = tid2;
                asm volatile("" : "+v"(tid3));
                const int lane = tid3 & 63, wid = tid3 >> 6;
                float* t = reinterpret_cast<float*>(smem) + wid * (64 * 65);
                conv_wave_loop(p, 1, l * 3072 + wid * 128 + (it - 128), 128 * 8, l * 3072 + 3072, t, lane);
            }
        }
    }
}

__device__ __forceinline__ float4 bf4_to_f4(uint2 u) {
    return make_float4(__uint_as_float(u.x << 16), __uint_as_float(u.x & 0xFFFF0000u), __uint_as_float(u.y << 16), __uint_as_float(u.y & 0xFFFF0000u));
}
__device__ __forceinline__ void phase_wout(const Params& p, int l, int bid, int nb, char* smem, const int tid) {
    const bf16_t* mix = reinterpret_cast<const bf16_t*>(p.ws + WS_MIX);
    const bf16_t* wt = reinterpret_cast<const bf16_t*>(p.ws + WS_WOUTT) + (size_t)l * 1024 * 1024;
    bf16_t* xcur = reinterpret_cast<bf16_t*>(p.ws + WS_XCUR);
    const float* g1 = mod_ptr(p, l, 0, 2);
    for (int tile = bid; tile < 256; tile += nb) {
        const int xcd = tile & 7, jj = tile >> 3;
        const int mt = xcd * 8 + (jj >> 2), nt = jj & 3;
        f32x4 acc[2][2][4][2];
        const int et = gemm256<true>(acc, p.ws, WS_MIX, [&](int r) { return (mt * 256 + r) * 1024; }, WS_WOUT8 + ((size_t)(l * 1024 + nt * 256) * 1024), 1024, 1024, smem, tid);
        const int lane = et & 63, wid = et >> 6, wr = wid >> 2, wc = wid & 3, fr = lane & 15, fq = lane >> 4;
        float4 g4[2][2];
#pragma unroll
        for (int bj = 0; bj < 2; ++bj)
#pragma unroll
            for (int n = 0; n < 2; ++n) g4[bj][n] = *reinterpret_cast<const float4*>(g1 + nt * 256 + bj * 128 + wc * 32 + n * 16 + fq * 4);
        if (l == 0) {
#pragma unroll
            for (int ai = 0; ai < 2; ++ai) {
                {
                    const float* gsrc = p.in[I_X] + (size_t)(mt * 256 + ai * 128 + wid * 16) * 1024 + nt * 256;
#pragma unroll 2
                    for (int j = 0; j < 16; ++j)
                        __builtin_amdgcn_global_load_lds((const unsigned*)(gsrc + (size_t)j * 1024 + ((lane ^ j) << 2)),
                                                         (LAS unsigned*)((LAS unsigned char*)smem + (wid * 16 + j) * 1024), 16, 0, 2);
                }
                asm volatile("s_waitcnt vmcnt(0)" ::: "memory");
                __syncthreads();
#pragma unroll
                for (int bj = 0; bj < 2; ++bj)
#pragma unroll
                    for (int m = 0; m < 4; ++m)
#pragma unroll
                        for (int n = 0; n < 2; ++n) {
                            const int rl = wr * 64 + m * 16 + fr;
                            const int slot = (bj * 32 + wc * 8 + n * 4 + fq) ^ fr;
                            char* sp_ = smem + rl * 1024 + slot * 16;
                            const float4 x4 = *reinterpret_cast<const float4*>(sp_);
                            const f32x4 a = acc[ai][bj][m][n];
                            const float4 g = g4[bj][n];
                            *reinterpret_cast<uint2*>(sp_) = make_uint2(pack2(x4.x + g.x * a[0], x4.y + g.y * a[1]), pack2(x4.z + g.z * a[2], x4.w + g.w * a[3]));
                        }
                __syncthreads();
#pragma unroll 4
                for (int k = 0; k < 16; ++k) {
                    const int rl = k * 8 + wid;
                    const uint2 v = *reinterpret_cast<const uint2*>(smem + rl * 1024 + lane * 16);
                    *reinterpret_cast<uint2*>(xcur + (size_t)(mt * 256 + ai * 128 + rl) * 1024 + nt * 256 + ((lane ^ (rl & 15)) << 2)) = v;
                }
                __syncthreads();
            }
        } else {
#pragma unroll
            for (int ai = 0; ai < 2; ++ai) {
                const bf16_t* gsrc = xcur + (size_t)(mt * 256 + ai * 128 + wid * 16) * 1024 + nt * 256;
#pragma unroll 2
                for (int j = 0; j < 8; ++j) {
                    const int rr = 2 * j + (lane >> 5);
                    __builtin_amdgcn_global_load_lds((const unsigned*)(gsrc + (size_t)rr * 1024 + (((lane & 31) ^ (rr & 15)) << 3)),
                                                     (LAS unsigned*)((LAS unsigned char*)smem + ai * 65536 + (wid * 16 + 2 * j) * 512), 16, 0, 0);
                }
            }
            asm volatile("s_waitcnt vmcnt(0)" ::: "memory");
            __syncthreads();
#pragma unroll
            for (int ai = 0; ai < 2; ++ai)
#pragma unroll
                for (int bj = 0; bj < 2; ++bj)
#pragma unroll
                    for (int m = 0; m < 4; ++m)
#pragma unroll
                        for (int n = 0; n < 2; ++n) {
                            const int rl = wr * 64 + m * 16 + fr;
                            const int slot = (bj * 16 + wc * 4 + n * 2 + (fq >> 1)) ^ fr;
                            char* sp_ = smem + ai * 65536 + rl * 512 + slot * 16 + (fq & 1) * 8;
                            const float4 x4 = bf4_to_f4(*reinterpret_cast<const uint2*>(sp_));
                            const f32x4 a = acc[ai][bj][m][n];
                            const float4 g = g4[bj][n];
                            *reinterpret_cast<uint2*>(sp_) = make_uint2(pack2(x4.x + g.x * a[0], x4.y + g.y * a[1]), pack2(x4.z + g.z * a[2], x4.w + g.w * a[3]));
                        }
            __syncthreads();
#pragma unroll 4
            for (int k = 0; k < 16; ++k) {
                const int rl2 = k * 16 + wid * 2 + (lane >> 5);
                const u32x4 v = *reinterpret_cast<const u32x4*>(smem + (rl2 >> 7) * 65536 + (rl2 & 127) * 512 + (lane & 31) * 16);
                *reinterpret_cast<u32x4*>(xcur + (size_t)(mt * 256 + rl2) * 1024 + nt * 256 + (((lane & 31) ^ (rl2 & 15)) << 3)) = v;
            }
            __syncthreads();
        }
    }
    if (l == 0) {
        const float* g1c = mod_ptr(p, 0, 1, 2);
        const float* csrc = p.in[I_CTX];
        for (int it = bid; it < 8 * 32; it += nb) {
            const int mb = it >> 5, nbk = it & 31;
            mini_gemm(mix + (size_t)SEQ * 1024, 1024, wt, 1024, 1024, mb, nbk, smem, tid, [&](int r, int c, float v0, float v1) {
                float2 xv = *reinterpret_cast<const float2*>(csrc + (size_t)r * 1024 + c);
                float2 g2v = *reinterpret_cast<const float2*>(g1c + c);
                *reinterpret_cast<unsigned*>(xcur + (size_t)(SEQ + r) * 1024 + c) = pack2(xv.x + g2v.x * v0, xv.y + g2v.y * v1);
            });
        }
    }
}

__device__ __forceinline__ void router_stage(const Params& p, int l, int bid, int nb, char* smem, const int t, const int nthr) {
    const int nbx = (l == 1) ? nb : nb - 4;
    const int lv = l * 2 + (bid >= nbx ? 1 : 0);
    const u32x4* src = reinterpret_cast<const u32x4*>(p.ws + WS_WPRIME + (size_t)lv * 131072);
#pragma unroll 1
    for (int i0 = 0; i0 < 8192; i0 += 8 * nthr) {
        u32x4 v[8];
#pragma unroll
        for (int j = 0; j < 8; ++j) { const int i = i0 + j * nthr + t; v[j] = src[i < 8192 ? i : 8191]; }
        __builtin_amdgcn_sched_barrier(0);
#pragma unroll
        for (int j = 0; j < 8; ++j) { const int i = i0 + j * nthr + t; if (i < 8192) reinterpret_cast<u32x4*>(smem)[i] = v[j]; }
        __builtin_amdgcn_sched_barrier(0);
    }
    for (int i = t; i < 512; i += nthr) {
        const float2 g2 = *reinterpret_cast<const float2*>(reinterpret_cast<const float*>(p.ws + WS_GP) + lv * 1024 + 2 * i);
        const float2 b2 = *reinterpret_cast<const float2*>(mod_ptr(p, l, lv & 1, 3) + 2 * i);
        reinterpret_cast<unsigned*>(smem + 131072)[i] = pack2(g2.x, g2.y);
        reinterpret_cast<unsigned*>(smem + 131072 + 2048)[i] = pack2(b2.x, b2.y);
    }
}
__device__ __forceinline__ void phase_router(const Params& p, int l, int bid, int nb, char* smem, const int tid, const bool staged = false) {
    const int lane = tid & 63, wid = __builtin_amdgcn_readfirstlane(tid >> 6), fr = lane & 15, fq = lane >> 4;
    const bool last = (l == 1);
    const bf16_t* xcur = reinterpret_cast<const bf16_t*>(p.ws + WS_XCUR);
    unsigned char* hA8 = reinterpret_cast<unsigned char*>(p.ws + WS_HA);
    const float* brt = p.in[I_BROUTER];
    int* cntl = reinterpret_cast<int*>(p.ws + WS_CNT) + l * 8 * 32 * CNT_STRIDE;
    int* toklist = reinterpret_cast<int*>(p.ws + WS_TOKLIST);
    int* tokinfo = reinterpret_cast<int*>(p.ws + WS_TOKINFO);
    float* tokw = reinterpret_cast<float*>(p.ws + WS_TOKW);
    const int nbx = last ? nb : nb - 4;
    const bool isctx = bid >= nbx;
    const int lv = l * 2 + (isctx ? 1 : 0);
    int tile; bool active;
    if (!isctx) { tile = wid * nbx + bid; active = tile < SEQ / 16; }
    else { tile = SEQ / 16 + wid * 4 + (bid - nbx); active = wid < 4; }
    if (!staged) router_stage(p, l, bid, nb, smem, tid, NTHREADS);
    __syncthreads();
    if (!active) return;
    float* ssc = reinterpret_cast<float*>(smem + 131072 + 4096 + wid * 2304);
    int* wcnt = reinterpret_cast<int*>(ssc + 512);
    int* wbase = wcnt + 32;
    if (lane < 32) wcnt[lane] = 0;
    const int r0 = tile * 16;
    const float* rb = reinterpret_cast<const float*>(p.ws + WS_RB) + lv * 32;
    u32x4 xf[32];
    {
        const bf16_t* xrow = xcur + (size_t)(r0 + fr) * 1024 + fq * 8;
#pragma unroll
        for (int ks = 0; ks < 32; ++ks) xf[ks] = *reinterpret_cast<const u32x4*>(xrow + ks * 32);
    }
    __builtin_amdgcn_sched_barrier(0);
    f32x4 acc0 = {0.f, 0.f, 0.f, 0.f}, acc1 = {0.f, 0.f, 0.f, 0.f};
    float ssq = 0.f;
#pragma unroll
    for (int ks = 0; ks < 32; ++ks) {
        const char* wl = smem + ks * 4096 + lane * 16;
        const bf16x8 wh0 = *reinterpret_cast<const bf16x8*>(wl), wh1 = *reinterpret_cast<const bf16x8*>(wl + 1024);
        const bf16x8 wl0 = *reinterpret_cast<const bf16x8*>(wl + 2048), wl1 = *reinterpret_cast<const bf16x8*>(wl + 3072);
        const bf16x8 xb = __builtin_bit_cast(bf16x8, xf[ks]);
        acc0 = __builtin_amdgcn_mfma_f32_16x16x32_bf16(wh0, xb, acc0, 0, 0, 0);
        acc1 = __builtin_amdgcn_mfma_f32_16x16x32_bf16(wh1, xb, acc1, 0, 0, 0);
        acc0 = __builtin_amdgcn_mfma_f32_16x16x32_bf16(wl0, xb, acc0, 0, 0, 0);
        acc1 = __builtin_amdgcn_mfma_f32_16x16x32_bf16(wl1, xb, acc1, 0, 0, 0);
#pragma unroll
        for (int q = 0; q < 4; ++q) {
            const float a = __uint_as_float(xf[ks][q] << 16), b = __uint_as_float(xf[ks][q] & 0xFFFF0000u);
            ssq = fmaf(a, a, ssq); ssq = fmaf(b, b, ssq);
        }
        if ((ks & 3) == 3) __builtin_amdgcn_sched_barrier(0);
    }
    ssq += __shfl_xor(ssq, 16, 64);
    ssq += __shfl_xor(ssq, 32, 64);
    const float rs = rsqrtf(ssq * (1.f / 1024.f) + 1e-6f);
#pragma unroll
    for (int j = 0; j < 4; ++j) {
        const int e0 = fq * 4 + j, e1 = 16 + fq * 4 + j;
        ssc[fr * 32 + e0] = 1.f / (1.f + expf(-(rs * acc0[j] + rb[e0])));
        ssc[fr * 32 + e1] = 1.f / (1.f + expf(-(rs * acc1[j] + rb[e1])));
    }
    asm volatile("s_waitcnt lgkmcnt(0)" ::: "memory");
    int pe0 = 0, pe1 = 0, rk0 = 0, rk1 = 0;
    if (lane < 16) {
        const int r = r0 + lane;
        const float* sv = ssc + lane * 32;
        int bestg = 0; float bestv = -1e30f;
#pragma unroll 1
        for (int gq = 0; gq < 4; ++gq) {
            float m1 = -1e30f, m2 = -1e30f;
#pragma unroll
            for (int i = 0; i < 8; ++i) {
                const float x = sv[gq * 8 + i] + brt[gq * 8 + i];
                if (x > m1) { m2 = m1; m1 = x; } else if (x > m2) m2 = x;
            }
            const float gs = m1 + m2;
            if (gs > bestv) { bestv = gs; bestg = gq; }
        }
        int e0 = 0, e1 = 0; float v0 = -1e30f, v1 = -1e30f;
#pragma unroll
        for (int i = 0; i < 8; ++i) {
            const int e = bestg * 8 + i;
            const float x = sv[e] + brt[e];
            if (x > v0) { v1 = v0; e1 = e0; v0 = x; e0 = e; }
            else if (x > v1) { v1 = x; e1 = e; }
        }
        const float s0 = sv[e0], s1 = sv[e1];
        const float inv = 1.f / (s0 + s1);
        *reinterpret_cast<float2*>(tokw + r * 2) = make_float2(s0 * inv, s1 * inv);
        pe0 = e0; pe1 = e1;
        rk0 = atomicAdd(&wcnt[e0], 1);
        rk1 = atomicAdd(&wcnt[e1], 1);
    }
    asm volatile("s_waitcnt lgkmcnt(0)" ::: "memory");
    if (lane < 32) {
        const int c = wcnt[lane];
        wbase[lane] = c > 0 ? atomicAdd(&cntl[((tile & 7) * 32 + lane) * CNT_STRIDE], c) : 0;
    }
    asm volatile("s_waitcnt vmcnt(0) lgkmcnt(0)" ::: "memory");
    if (lane < 16) {
        const int r = r0 + lane;
        const int p0 = wbase[pe0] + rk0, p1 = wbase[pe1] + rk1;
        toklist[pe0 * ROWS + (tile & 7) * SUBCAP + p0] = r;
        toklist[pe1 * ROWS + (tile & 7) * SUBCAP + p1] = r;
        *reinterpret_cast<int4*>(tokinfo + r * 4) = make_int4(pe0, p0, pe1, p1);
    }
    {
#pragma unroll
        for (int ks = 0; ks < 32; ++ks) asm volatile("" : "+v"(xf[ks]));
        unsigned char* hrow = hA8 + (size_t)(r0 + fr) * 1024 + fq * 8;
        const char* gt = smem + 131072 + fq * 16, *bt = gt + 2048;
#pragma unroll
        for (int ks = 0; ks < 32; ++ks) {
            const u32x4 g8 = *reinterpret_cast<const u32x4*>(gt + ks * 64), b8 = *reinterpret_cast<const u32x4*>(bt + ks * 64);
            float o[8];
#pragma unroll
            for (int q = 0; q < 4; ++q) {
                o[2 * q]     = __uint_as_float(xf[ks][q] << 16) * rs * __uint_as_float(g8[q] << 16) + __uint_as_float(b8[q] << 16);
                o[2 * q + 1] = __uint_as_float(xf[ks][q] & 0xFFFF0000u) * rs * __uint_as_float(g8[q] & 0xFFFF0000u) + __uint_as_float(b8[q] & 0xFFFF0000u);
            }
            int q0 = __builtin_amdgcn_cvt_pk_fp8_f32(o[0], o[1], 0, false);
            q0 = __builtin_amdgcn_cvt_pk_fp8_f32(o[2], o[3], q0, true);
            int q1 = __builtin_amdgcn_cvt_pk_fp8_f32(o[4], o[5], 0, false);
            q1 = __builtin_amdgcn_cvt_pk_fp8_f32(o[6], o[7], q1, true);
            *reinterpret_cast<uint2*>(hrow + ks * 32) = make_uint2((unsigned)q0, (unsigned)q1);
            if ((ks & 3) == 3) __builtin_amdgcn_sched_barrier(0);
        }
    }
}

__device__ __forceinline__ void moe_prefix(const Params& p, int l, int* sm, const int tid) {
    __syncthreads();
    if (tid < 256) {
        const int* cnt = reinterpret_cast<const int*>(p.ws + WS_CNT) + l * 8 * 32 * CNT_STRIDE;
        const int e = tid >> 3, g = tid & 7;
        const int c = cnt[(g * 32 + e) * CNT_STRIDE];
        int incl = c;
#pragma unroll
        for (int d = 1; d < 8; d <<= 1) { const int t = __shfl_up(incl, d, 8); if (g >= d) incl += t; }
        sm[64 + tid] = incl - c;
        if (g == 7) sm[320 + e] = incl;
    }
    __syncthreads();
    if (tid < 64) {
        const int c = tid < 32 ? sm[320 + tid] : 0;
        int incl = c;
#pragma unroll
        for (int d = 1; d < 32; d <<= 1) { const int t = __shfl_up(incl, d, 64); if (tid >= d) incl += t; }
        if (tid < 32) sm[tid] = incl - c;
        if (tid == 31) sm[32] = incl;
    }
    __syncthreads();
}
__device__ __forceinline__ void moe_tile(const int* sm, const int* cnt, int tm, int& e, int& mt) {
    const int nfull = sm[65], nbig = sm[98];
    int e_ = 0;
    if (tm < nfull) {
        while (sm[33 + e_ + 1] <= tm) ++e_;
        e = __builtin_amdgcn_readfirstlane(e_);
        mt = __builtin_amdgcn_readfirstlane(tm - sm[33 + e]);
    } else {
        const int off = tm < nfull + nbig ? 66 : 99;
        const int tq = tm < nfull + nbig ? tm - nfull : tm - nfull - nbig;
        while (sm[off + e_ + 1] <= tq) ++e_;
        e = __builtin_amdgcn_readfirstlane(e_);
        mt = __builtin_amdgcn_readfirstlane(cnt[e * CNT_STRIDE] >> 8);
    }
}

__device__ __forceinline__ void phase_moe(const Params& p, int l, int bid, int nb, char* smem, const int tid) {
    int* sm = reinterpret_cast<int*>(smem + LDS_SM_OFF);
    moe_prefix(p, l, sm, tid);
    volatile int* sit = reinterpret_cast<volatile int*>(smem + LDS_SM_OFF + 4096);
    const int* toklist = reinterpret_cast<const int*>(p.ws + WS_TOKLIST);
    bf16_t* hid = reinterpret_cast<bf16_t*>(p.ws + WS_UX);
    bf16_t* ybuf = reinterpret_cast<bf16_t*>(p.ws + WS_PD);
    const int vx = bid & 7;
    unsigned* qhead = reinterpret_cast<unsigned*>(p.ws + WS_MQ) + (l * 8 + vx) * 64;
    unsigned* dep = reinterpret_cast<unsigned*>(p.ws + WS_MDEP) + (size_t)l * 32 * 72;
    int* ord = sm + 352;
    int* gl = sm + 384;
    int* gn = sm + 640;
    if (tid < 32) {
        const int te = (sm[320 + tid] + 255) >> 8;
        int rank = 0;
#pragma unroll
        for (int j = 0; j < 32; ++j) { const int tj = (sm[320 + j] + 255) >> 8; rank += (tj > te || (tj == te && j < tid)) ? 1 : 0; }
        ord[rank] = tid;
    }
    __syncthreads();
    if (tid == 0) {
        int oe[32], ot[32];
#pragma unroll
        for (int i = 0; i < 32; ++i) oe[i] = ord[i];
#pragma unroll
        for (int i = 0; i < 32; ++i) ot[i] = (sm[320 + oe[i]] + 255) >> 8;
        int L0 = 0, L1 = 0, L2 = 0, L3 = 0, L4 = 0, L5 = 0, L6 = 0, L7 = 0;
        int N0 = 0, N1 = 0, N2 = 0, N3 = 0, N4 = 0, N5 = 0, N6 = 0, N7 = 0;
#pragma unroll
        for (int i = 0; i < 32; ++i) {
            int b = 0, bl = L0;
            if (L1 < bl) { bl = L1; b = 1; }
            if (L2 < bl) { bl = L2; b = 2; }
            if (L3 < bl) { bl = L3; b = 3; }
            if (L4 < bl) { bl = L4; b = 4; }
            if (L5 < bl) { bl = L5; b = 5; }
            if (L6 < bl) { bl = L6; b = 6; }
            if (L7 < bl) { bl = L7; b = 7; }
            const int nb_ = b == 0 ? N0 : b == 1 ? N1 : b == 2 ? N2 : b == 3 ? N3 : b == 4 ? N4 : b == 5 ? N5 : b == 6 ? N6 : N7;
            gl[b * 32 + nb_] = oe[i];
            const int t = ot[i];
            L0 += b == 0 ? t : 0; L1 += b == 1 ? t : 0; L2 += b == 2 ? t : 0; L3 += b == 3 ? t : 0;
            L4 += b == 4 ? t : 0; L5 += b == 5 ? t : 0; L6 += b == 6 ? t : 0; L7 += b == 7 ? t : 0;
            N0 += b == 0; N1 += b == 1; N2 += b == 2; N3 += b == 3; N4 += b == 4; N5 += b == 5; N6 += b == 6; N7 += b == 7;
        }
        gn[0] = N0; gn[1] = N1; gn[2] = N2; gn[3] = N3; gn[4] = N4; gn[5] = N5; gn[6] = N6; gn[7] = N7;
        gn[8] = L0; gn[9] = L1; gn[10] = L2; gn[11] = L3; gn[12] = L4; gn[13] = L5; gn[14] = L6; gn[15] = L7;
    }
    __syncthreads();
    const int ne = __builtin_amdgcn_readfirstlane(gn[vx]);
    const int n1 = __builtin_amdgcn_readfirstlane(gn[8 + vx]) * 4;
    const int* mylist = gl + vx * 32;
    unsigned* pend = nullptr;
    auto flush = [&](int t0) {
        if (pend != nullptr) {
            asm volatile("s_waitcnt vmcnt(0)" ::: "memory");
            __syncthreads();
            if (t0 == 0) __hip_atomic_fetch_add(pend, 1u, __ATOMIC_RELAXED, __HIP_MEMORY_SCOPE_AGENT);
            pend = nullptr;
        }
    };
    int nxt = 0;
    if (tid == 0) nxt = (int)__hip_atomic_fetch_add(qhead, 1u, __ATOMIC_RELAXED, __HIP_MEMORY_SCOPE_AGENT);
    for (;;) {
        __syncthreads();
        if (tid == 0) *sit = nxt;
        __syncthreads();
        const int itq = __builtin_amdgcn_readfirstlane(*sit);
        if (itq >= 2 * n1) { flush(tid); break; }
        const bool g2 = itq >= n1;
        const int it = g2 ? itq - n1 : itq;
        const int tm = it >> 2, nt = it & 3;
        int e = 0, mt = 0, ce = 0;
        {
            int tb = 0;
#pragma unroll 1
            for (int k = 0; k < ne; ++k) {
                const int ek = __builtin_amdgcn_readfirstlane(mylist[k]);
                const int ck = __builtin_amdgcn_readfirstlane(sm[320 + ek]);
                const int tk = (ck + 255) >> 8;
                if (tm < tb + tk) { e = ek; mt = tm - tb; ce = ck; break; }
                tb += tk;
            }
        }
        const int roff = __builtin_amdgcn_readfirstlane(sm[e]);
        unsigned* dp = dep + e * 72 + (mt < 72 ? mt : 71);
        if (!g2) {
            const int* tl = toklist + e * ROWS;
            int sp[8];
#pragma unroll
            for (int j = 0; j < 8; ++j) sp[j] = __builtin_amdgcn_readfirstlane(sm[64 + e * 8 + j]);
            f32x4 acc[2][2][4][2];
            const int et = gemm256<true>(acc, p.ws, WS_HA, [&](int r) { int rr = mt * 256 + r; rr = rr < ce ? rr : ce - 1;
                                                                    int g = 0;
#pragma unroll
                                                                    for (int j = 1; j < 8; ++j) g += (sp[j] <= rr) ? 1 : 0;
                                                                    int so = sp[0];
#pragma unroll
                                                                    for (int j = 1; j < 8; ++j) so = (j == g) ? sp[j] : so;
                                                                    return tl[g * SUBCAP + rr - so] * 1024; }, WS_W1T + (((size_t)(l * 32 + e) * 1024 + nt * 256) * 1024), 1024, 1024, smem, tid, ce - mt * 256);
            flush(et);
            if (et == 0) nxt = (int)__hip_atomic_fetch_add(qhead, 1u, __ATOMIC_RELAXED, __HIP_MEMORY_SCOPE_AGENT);
            const int lane = et & 63, wid = et >> 6, wr = wid >> 2, wc = wid & 3, fr = lane & 15, fq = lane >> 4;
            constexpr int HS = 144;
#pragma unroll
            for (int ai = 0; ai < 2; ++ai)
#pragma unroll
                for (int m = 0; m < 4; ++m)
#pragma unroll
                    for (int bj = 0; bj < 2; ++bj) {
                        float o[4];
#pragma unroll
                        for (int j = 0; j < 4; ++j) {
                            const float gte = acc[ai][bj][m][0][j], up = acc[ai][bj][m][1][j];
                            o[j] = gte * sigmoidf_fast(gte) * up;
                        }
                        const int rl = ai * 128 + wr * 64 + m * 16 + fr, cl = bj * 64 + wc * 16 + fq * 4;
                        int q8 = __builtin_amdgcn_cvt_pk_fp8_f32(o[0], o[1], 0, false);
                        q8 = __builtin_amdgcn_cvt_pk_fp8_f32(o[2], o[3], q8, true);
                        *reinterpret_cast<int*>(smem + rl * HS + cl) = q8;
                    }
            __syncthreads();
            {
                const int seg = et & 7, rq = et >> 3;
#pragma unroll
                for (int i = 0; i < 4; ++i) {
                    const int rl = i * 64 + rq, rloc = mt * 256 + rl;
                    const u32x4 v = *reinterpret_cast<const u32x4*>(smem + rl * HS + seg * 16);
                    if (rloc < ce) {
                        const unsigned char* dst = reinterpret_cast<const unsigned char*>(hid) + (size_t)(roff + rloc) * 512 + nt * 128 + seg * 16;
                        asm volatile("global_store_dwordx4 %0, %1, off sc1\n\ts_nop 1" :: "v"(dst), "v"(v) : "memory");
                    }
                }
            }
            pend = dp;
        } else {
            flush(tid);
            if (tid == 0) {
                unsigned spins = 0;
                while (__hip_atomic_load(dp, __ATOMIC_RELAXED, __HIP_MEMORY_SCOPE_AGENT) < 4u) { __builtin_amdgcn_s_sleep(2); if (++spins > (1u << 22)) break; }
                __builtin_amdgcn_fence(__ATOMIC_ACQUIRE, "agent");
                asm volatile("s_waitcnt vmcnt(0)" ::: "memory");
            }
            __syncthreads();
            f32x4 acc[2][2][4][2];
            const int et = gemm256<true>(acc, p.ws, WS_UX, [&](int r) { int rr = mt * 256 + r; rr = rr < ce ? rr : ce - 1; return (roff + rr) * 512; }, WS_W2T + (((size_t)(l * 32 + e) * 1024 + nt * 256) * 512), 512, 512, smem, tid, ce - mt * 256);
            if (et == 0) nxt = (int)__hip_atomic_fetch_add(qhead, 1u, __ATOMIC_RELAXED, __HIP_MEMORY_SCOPE_AGENT);
            const int lane = et & 63, wid = et >> 6, wr = wid >> 2, wc = wid & 3, fr = lane & 15, fq = lane >> 4;
            store_tile_fp8(smem, et,
                [&](int ai, int bj, int m, int n) { const f32x4 a = acc[ai][bj][m][n];
                                                    int q8 = __builtin_amdgcn_cvt_pk_fp8_f32(a[0], a[1], 0, false);
                                                    return __builtin_amdgcn_cvt_pk_fp8_f32(a[2], a[3], q8, true); },
                [&](int r) -> unsigned char* { const int rloc = mt * 256 + r;
                                               return rloc < ce ? reinterpret_cast<unsigned char*>(ybuf) + (size_t)(roff + rloc) * 1024 + nt * 256 : nullptr; });
        }
    }
}


__device__ __forceinline__ void moe_prefix_wave(const Params& p, int l, int* sm, const int lane) {
    const int* cnt = reinterpret_cast<const int*>(p.ws + WS_CNT) + l * 8 * 32 * CNT_STRIDE;
    const int e = lane >> 1, h = lane & 1;
    int c[4];
#pragma unroll
    for (int j = 0; j < 4; ++j) c[j] = cnt[((h * 4 + j) * 32 + e) * CNT_STRIDE];
    const int tot = c[0] + c[1] + c[2] + c[3];
    const int oth = __shfl_xor(tot, 1, 64);
    const int base = h ? oth : 0;
    sm[64 + e * 8 + h * 4 + 0] = base;
    sm[64 + e * 8 + h * 4 + 1] = base + c[0];
    sm[64 + e * 8 + h * 4 + 2] = base + c[0] + c[1];
    sm[64 + e * 8 + h * 4 + 3] = base + c[0] + c[1] + c[2];
    const int te = tot + oth;
    int incl = h ? 0 : te;
#pragma unroll
    for (int d = 1; d < 64; d <<= 1) { const int v = __shfl_up(incl, d, 64); if (lane >= d) incl += v; }
    if (h == 0) { sm[320 + e] = te; sm[e] = incl - te; }
    if (lane == 63) sm[32] = incl;
}
__device__ __forceinline__ void phase_combine(const Params& p, int l, int bid, int nb, char* smem, const int tid, const bool staged = false) {
    const int lane = tid & 63, wid = tid >> 6;
    const bool last = (l == 1);
    int* sm = reinterpret_cast<int*>(smem);
    if (!staged) moe_prefix(p, l, sm, tid);
    __syncthreads();
    bf16_t* xcur = reinterpret_cast<bf16_t*>(p.ws + WS_XCUR);
    const bf16_t* ybuf = reinterpret_cast<const bf16_t*>(p.ws + WS_PD);
    bf16_t* hA = reinterpret_cast<bf16_t*>(p.ws + WS_HA);
    const int* tokinfo = reinterpret_cast<const int*>(p.ws + WS_TOKINFO);
    const float* tokw = reinterpret_cast<const float*>(p.ws + WS_TOKW);
    const int stride = nb * 8;
#pragma unroll 1
    for (int v = 0; v < (last ? 1 : 2); ++v) {
        const int rbeg = v == 0 ? 0 : SEQ, rend = v == 0 ? SEQ : ROWS;
        float4 g2r[4], ga[4], bb[4];
        {
            const float* g2 = mod_ptr(p, l, v, 5);
            const float* gm = last ? p.in[I_GFINAL] : p.in[I_GMIX] + 1024;
            const float* sh = mod_ptr(p, 1, v, 0);
            const float* sc = mod_ptr(p, 1, v, 1);
#pragma unroll
            for (int i = 0; i < 4; ++i) {
                const int k = i * 256 + lane * 4;
                g2r[i] = *reinterpret_cast<const float4*>(g2 + k);
                const float4 g = *reinterpret_cast<const float4*>(gm + k);
                if (last) { ga[i] = g; bb[i] = make_float4(0.f, 0.f, 0.f, 0.f); }
                else {
                    const float4 a = *reinterpret_cast<const float4*>(sc + k);
                    ga[i] = make_float4(g.x * (1.f + a.x), g.y * (1.f + a.y), g.z * (1.f + a.z), g.w * (1.f + a.w));
                    bb[i] = *reinterpret_cast<const float4*>(sh + k);
                }
            }
        }
        int r = rbeg + bid * 8 + wid;
        int4 ti = make_int4(0, 0, 0, 0); float2 tw = make_float2(0.f, 0.f);
        if (r < rend) { ti = *reinterpret_cast<const int4*>(tokinfo + r * 4); tw = *reinterpret_cast<const float2*>(tokw + r * 2); }
#pragma unroll 1
        while (r < rend) {
            const int rn = r + stride;
            int4 tin = ti; float2 twn = tw;
            if (rn < rend) { tin = *reinterpret_cast<const int4*>(tokinfo + rn * 4); twn = *reinterpret_cast<const float2*>(tokw + rn * 2); }
            const int tg = (r >> 4) & 7;
            const unsigned char* y0 = reinterpret_cast<const unsigned char*>(ybuf) + (size_t)(sm[ti.x] + sm[64 + ti.x * 8 + tg] + ti.y) * 1024 + lane * 4;
            const unsigned char* y1 = reinterpret_cast<const unsigned char*>(ybuf) + (size_t)(sm[ti.z] + sm[64 + ti.z * 8 + tg] + ti.w) * 1024 + lane * 4;
            const float w0 = tw.x, w1 = tw.y;
            float4 xv[4]; int ya[4], yb[4];
#pragma unroll
            for (int i = 0; i < 4; ++i) {
                xv[i] = bf4_to_f4(*reinterpret_cast<const uint2*>(xcur + (size_t)r * 1024 + i * 256 + lane * 4));
                ya[i] = *reinterpret_cast<const int*>(y0 + i * 256);
                yb[i] = *reinterpret_cast<const int*>(y1 + i * 256);
            }
            float ss = 0.f;
#pragma unroll
            for (int i = 0; i < 4; ++i) {
                const f32x2 a01 = __builtin_amdgcn_cvt_pk_f32_fp8(ya[i], false), a23 = __builtin_amdgcn_cvt_pk_f32_fp8(ya[i], true);
                const f32x2 b01 = __builtin_amdgcn_cvt_pk_f32_fp8(yb[i], false), b23 = __builtin_amdgcn_cvt_pk_f32_fp8(yb[i], true);
                xv[i].x += g2r[i].x * (w0 * a01[0] + w1 * b01[0]);
                xv[i].y += g2r[i].y * (w0 * a01[1] + w1 * b01[1]);
                xv[i].z += g2r[i].z * (w0 * a23[0] + w1 * b23[0]);
                xv[i].w += g2r[i].w * (w0 * a23[1] + w1 * b23[1]);
                ss += xv[i].x * xv[i].x + xv[i].y * xv[i].y + xv[i].z * xv[i].z + xv[i].w * xv[i].w;
            }
            ss = wave_sum(ss);
            const float rstd = rsqrtf(ss * (1.f / 1024.f) + 1e-6f);
#pragma unroll
            for (int i = 0; i < 4; ++i) {
                const int k = i * 256 + lane * 4;
                const float o0 = xv[i].x * rstd * ga[i].x + bb[i].x, o1 = xv[i].y * rstd * ga[i].y + bb[i].y;
                const float o2 = xv[i].z * rstd * ga[i].z + bb[i].z, o3 = xv[i].w * rstd * ga[i].w + bb[i].w;
                if (!last) {
                    *reinterpret_cast<uint2*>(xcur + (size_t)r * 1024 + k) = make_uint2(pack2(xv[i].x, xv[i].y), pack2(xv[i].z, xv[i].w));
                    if (v == 0) {
                        int q8 = __builtin_amdgcn_cvt_pk_fp8_f32(o0, o1, 0, false);
                        q8 = __builtin_amdgcn_cvt_pk_fp8_f32(o2, o3, q8, true);
                        *reinterpret_cast<int*>(reinterpret_cast<unsigned char*>(hA) + (size_t)r * 1024 + k) = q8;
                    } else
                        *reinterpret_cast<uint2*>(reinterpret_cast<bf16_t*>(p.ws + WS_HACTX) + (size_t)(r - SEQ) * 1024 + k) = make_uint2(pack2(o0, o1), pack2(o2, o3));
                } else {
                    __builtin_nontemporal_store(f32x4{o0, o1, o2, o3}, reinterpret_cast<f32x4*>(p.out + (size_t)r * 1024 + k));
                }
            }
            ti = tin; tw = twn; r = rn;
        }
    }
}


#define XB_TMO      128
#define XB_XCNT(j)  (256  + 64 * (j))
#define XB_XSUB(j)  (1280 + 64 * (j))
#define XB_XGEN(j)  (2304 + 64 * (j))
#define XB_TOP      3328
#define XB_TOPGEN   3392
#define XB_XFLAG    3520
#define XCD_BAR_WORDS 3456
#define XB_SPIN_CAP (1u << 20)
__device__ __forceinline__ unsigned xb_ld(unsigned* p)              { return __hip_atomic_load(p, __ATOMIC_RELAXED, __HIP_MEMORY_SCOPE_AGENT); }
__device__ __forceinline__ unsigned xb_add(unsigned* p, unsigned v) { return __hip_atomic_fetch_add(p, v, __ATOMIC_RELAXED, __HIP_MEMORY_SCOPE_AGENT); }
__device__ __forceinline__ unsigned xb_xcc_id() { return (unsigned)__builtin_amdgcn_s_getreg((3 << 11) | 20) & 0xFu; }
#define XB_SPIN(cond, bar) do { unsigned _sp = 0; while (cond) { __builtin_amdgcn_s_sleep(1); \
    if ((++_sp & 255u) == 0u) { if (xb_ld(&(bar)[XB_TMO])) break; if (_sp > XB_SPIN_CAP) { atomicAdd(&(bar)[XB_TMO], 1u); break; } } } } while (0)
struct XcdBarrier { unsigned* bar; unsigned x; volatile LAS unsigned* st; };
__device__ __forceinline__ XcdBarrier xcd_barrier_post(unsigned* bar, volatile LAS unsigned* st, int tid) {
    XcdBarrier b; b.bar = bar; b.x = xb_xcc_id(); b.st = st;
    if (tid == 0) (void)xb_add(&bar[XB_XCNT(b.x)], 1u);
    return b;
}
__device__ __forceinline__ void xcd_barrier_complete(unsigned* bar, unsigned x, unsigned& nloc, unsigned& nx) {
    const unsigned G = gridDim.x * gridDim.y * gridDim.z;
    unsigned sum, cnt, mine, sp = 0u;
    for (;;) {
        sum = 0u; cnt = 0u; mine = 0u;
#pragma unroll
        for (unsigned j = 0; j < 16; ++j) { const unsigned c = xb_ld(&bar[XB_XCNT(j)]); sum += c; cnt += (c > 0u) ? 1u : 0u; mine = (j == x) ? c : mine; }
        if (sum == G) break;
        __builtin_amdgcn_s_sleep(1);
        if ((++sp & 255u) == 0u) { if (xb_ld(&bar[XB_TMO])) break; if (sp > XB_SPIN_CAP) { atomicAdd(&bar[XB_TMO], 1u); break; } }
    }
    nloc = mine > 0u ? mine : 1u; nx = cnt > 0u ? cnt : 1u;
}
template <class Pre>
__device__ __forceinline__ void xcd2_barrier(const XcdBarrier& b, int tid, Pre pre) {
    asm volatile("s_waitcnt vmcnt(0)" ::: "memory");
    __syncthreads();
    if (tid >= 64) pre(tid - 64);
    if (tid < 64) {
        unsigned* bar = b.bar;
        unsigned nloc = b.st[0], mask = b.st[1];
        if (nloc == 0u) {
            const unsigned G = gridDim.x * gridDim.y * gridDim.z;
            unsigned sp = 0u;
            for (;;) {
                const unsigned c = tid < 16 ? xb_ld(&bar[XB_XCNT(tid)]) : 0u;
                unsigned sum = c;
#pragma unroll
                for (int d = 1; d < 16; d <<= 1) sum += __shfl_xor(sum, d, 64);
                sum = __shfl(sum, 0, 64);
                mask = (unsigned)__ballot(c > 0u);
                nloc = __shfl(c, (int)b.x, 64);
                if (sum == G) break;
                __builtin_amdgcn_s_sleep(1);
                if (++sp > XB_SPIN_CAP) break;
            }
            nloc = nloc > 0u ? nloc : 1u;
            if (tid == 0) { b.st[0] = nloc; b.st[1] = mask; }
        }
        unsigned gen = 0u;
        if (tid == 0) {
            const unsigned old = xb_add(&bar[XB_XSUB(b.x)], 1u);
            gen = old / nloc;
            if (old + 1u == (gen + 1u) * nloc) {
                __builtin_amdgcn_fence(__ATOMIC_RELEASE, "agent");
                asm volatile("s_waitcnt vmcnt(0)" ::: "memory");
                __hip_atomic_store(&bar[XB_XFLAG + b.x], gen + 1u, __ATOMIC_RELAXED, __HIP_MEMORY_SCOPE_AGENT);
            }
        }
        const unsigned target = (unsigned)__builtin_amdgcn_readfirstlane((int)gen) + 1u;
        const bool mine = tid < 16 && ((mask >> tid) & 1u);
        unsigned sp = 0u;
        for (;;) {
            const unsigned v = mine ? xb_ld(&bar[XB_XFLAG + tid]) : target;
            if (__all(v >= target)) break;
            __builtin_amdgcn_s_sleep(1);
            if (++sp > (1u << 22)) break;
        }
        __builtin_amdgcn_fence(__ATOMIC_ACQUIRE, "agent");
        asm volatile("s_waitcnt vmcnt(0)" ::: "memory");
    }
    __syncthreads();
}
__device__ __forceinline__ void xcd2_barrier(const XcdBarrier& b, int tid) { xcd2_barrier(b, tid, [](int) {}); }
__device__ __forceinline__ void xcd_barrier(const XcdBarrier& b, int tid) {
    asm volatile("s_waitcnt vmcnt(0)" ::: "memory");
    __syncthreads();
    if (tid == 0) {
        unsigned* bar = b.bar;
        __builtin_amdgcn_s_waitcnt(0);
        unsigned nloc = b.st[0], nx = b.st[1];
        if (nloc == 0u) { xcd_barrier_complete(bar, b.x, nloc, nx); b.st[0] = nloc; b.st[1] = nx; }
        const unsigned old = xb_add(&bar[XB_XSUB(b.x)], 1u);
        const unsigned gen = old / nloc;
        if (old + 1u == (gen + 1u) * nloc) {
            __builtin_amdgcn_fence(__ATOMIC_RELEASE, "agent");
            asm volatile("s_waitcnt vmcnt(0)" ::: "memory");
            const unsigned og = xb_add(&bar[XB_TOP], 1u);
            const unsigned tg = og / nx;
            if (og + 1u == (tg + 1u) * nx) xb_add(&bar[XB_TOPGEN], 1u);
            else XB_SPIN(xb_ld(&bar[XB_TOPGEN]) == tg, bar);
            __builtin_amdgcn_fence(__ATOMIC_ACQUIRE, "agent");
            xb_add(&bar[XB_XGEN(b.x)], 1u);
            asm volatile("s_waitcnt vmcnt(0)" ::: "memory");
        } else {
            XB_SPIN(xb_ld(&bar[XB_XGEN(b.x)]) == gen, bar);
            __builtin_amdgcn_fence(__ATOMIC_ACQUIRE, "agent");
            asm volatile("s_waitcnt vmcnt(0)" ::: "memory");
        }
    }
    __syncthreads();
}

constexpr int N_PHASES = 18;
constexpr int PH_PER_LAYER = 8;
__device__ __forceinline__ void run_phase(const Params& p, int ph, int bid, int nb, char* smem, const int tid, const bool staged = false) {
    if (ph == 0) { phase_prologue(p, bid, nb, smem, tid); return; }
    if (ph == 1) { phase_norm0(p, bid, nb, smem, tid); return; }
    const int l = (ph - 2) / PH_PER_LAYER, q = (ph - 2) % PH_PER_LAYER;
    switch (q) {
        case 0: phase_win(p, l, bid, nb, smem, tid); break;
        case 1: phase_s1(p, l, bid, nb, smem, tid); break;
        case 2: phase_s2(p, l, bid, nb, smem, tid, staged); break;
        case 3: phase_glu_pool(p, l, bid, nb, smem, tid); break;
        case 4: phase_wout(p, l, bid, nb, smem, tid); break;
        case 5: phase_router(p, l, bid, nb, smem, tid, staged); break;
        case 6: phase_moe(p, l, bid, nb, smem, tid); break;
        default: phase_combine(p, l, bid, nb, smem, tid, staged); break;
    }
}

__device__ __forceinline__ void pre_phase(const Params& p, int ph, int bid, int nb, char* smem, const int t) {
    if (ph < 2) return;
    const int l = (ph - 2) / PH_PER_LAYER, q = (ph - 2) % PH_PER_LAYER;
    if (q == 5) router_stage(p, l, bid, nb, smem, t, NTHREADS - 64);
    else if (q == 2) { if (bid < 256) ttab_stage(p, l, (bid & 7) * 4 + (bid >> 6), smem, t, NTHREADS - 64); }
    else if (q == 7) { if (t < 64) moe_prefix_wave(p, l, reinterpret_cast<int*>(smem), t); }
}
__global__ void __launch_bounds__(NTHREADS, 2) fwd_kernel(Params p, int ph_lo, int ph_hi) {
    extern __shared__ __attribute__((aligned(16))) char smem[];
    volatile LAS unsigned* st = (volatile LAS unsigned*)(smem + LDS_BYTES - 16);
    if (threadIdx.x == 0) { st[0] = 0u; st[1] = 0u; }
    __syncthreads();
    XcdBarrier xb = xcd_barrier_post(reinterpret_cast<unsigned*>(p.ws + WS_BAR), st, threadIdx.x);
    const int wave_s = __builtin_amdgcn_readfirstlane(threadIdx.x >> 6);
    for (int ph = ph_lo; ph < ph_hi; ++ph) {
        Params q = p;
        {
            size_t zoff = 0;
            asm volatile("" : "+s"(zoff));
            q.ws = p.ws + zoff;
            q.out = p.out + zoff;
        }
        int tid;
        asm volatile("v_mbcnt_lo_u32_b32 %0, -1, 0\n\tv_mbcnt_hi_u32_b32 %0, -1, %0" : "=v"(tid));
        tid += wave_s * 64;
        asm volatile("" : "+v"(tid));
        int bid = blockIdx.x;
        asm volatile("" : "+s"(bid));
        run_phase(q, ph, bid, gridDim.x, smem, tid, ph > ph_lo);
        if ((REP_MASK >> ph) & 1u) {
            xcd2_barrier(xb, tid);
            if (ph == 8 || ph == 16) {
                const int lq = (ph - 2) / PH_PER_LAYER;
                if (bid == 0) {
                    if (tid < 8) reinterpret_cast<unsigned*>(q.ws + WS_MQ)[(lq * 8 + tid) * 64] = 0u;
                    for (int i = tid; i < 32 * 72; i += NTHREADS) reinterpret_cast<unsigned*>(q.ws + WS_MDEP)[lq * 32 * 72 + i] = 0u;
                }
                xcd2_barrier(xb, tid);
            }
            if (ph == 7 || ph == 15) {
                if (bid == 0 && tid < 256) reinterpret_cast<int*>(q.ws + WS_CNT)[((ph - 2) / PH_PER_LAYER * 256 + tid) * CNT_STRIDE] = 0;
                xcd2_barrier(xb, tid);
            }
            if (ph == 0) phase_prologue(q, bid, gridDim.x, smem, tid, PRO_PART); else run_phase(q, ph, bid, gridDim.x, smem, tid);
        }
        if (ph + 1 < ph_hi) {
            if (ph_hi < 0) cg::this_grid().sync();
            xcd2_barrier(xb, tid, [&](int t) { pre_phase(q, ph + 1, bid, gridDim.x, smem, t); });
        }
    }
}

extern "C" void kernel_launch(void* const* d_in, const int* in_sizes, int n_in, void* d_out, int out_size, void* d_ws, size_t ws_size,
                              hipStream_t stream) {
    if (ws_size < WS_END) { fprintf(stderr, "kernel_launch: workspace too small: %zu < %zu\n", ws_size, (size_t)WS_END); return; }
    static int inited = 0;
    static int grid = 256;
    if (!inited) {
        inited = 1;
        hipFuncSetAttribute((const void*)fwd_kernel, hipFuncAttributeMaxDynamicSharedMemorySize, LDS_BYTES);
        int dev = 0, cus = 0, per_cu = 0;
        hipGetDevice(&dev);
        hipDeviceGetAttribute(&cus, hipDeviceAttributeMultiprocessorCount, dev);
        hipOccupancyMaxActiveBlocksPerMultiprocessor(&per_cu, (const void*)fwd_kernel, NTHREADS, LDS_BYTES);
        if (per_cu < 1) per_cu = 1;
        grid = cus;
        (void)hipGetLastError();
    }
    Params p{};
    for (int i = 0; i < 28; ++i) p.in[i] = (const float*)d_in[i];
    p.out = (float*)d_out;
    p.ws = (unsigned char*)d_ws;
#if ONE_LAUNCH
    hipMemsetAsync((char*)d_ws + WS_BAR, 0, WS_CTL_BYTES, stream);
    int lo = 0, hi = N_PHASES;
    void* args[] = {&p, &lo, &hi};
    hipError_t e = hipLaunchCooperativeKernel((const void*)fwd_kernel, dim3(grid), dim3(NTHREADS), args, LDS_BYTES, stream);
    if (e != hipSuccess) fprintf(stderr, "cooperative launch failed: %s (grid %d)\n", hipGetErrorString(e), grid);
#else
    for (int ph = 0; ph < N_PHASES; ++ph) {
        hipLaunchKernelGGL(fwd_kernel, dim3(grid), dim3(NTHREADS), LDS_BYTES, stream, p, ph, ph + 1);
    }
#endif
}
```
